# Optimizing an MI355X kernel written in HIP

```python
import math
import jax, jax.numpy as jnp
from jax import lax
import numpy as np

D_MODEL = 2048
BATCH = 1
SEQ = 16384
DEPTH = 2

N_BRANCH = 4
BRANCH_W = 1024

POOL_W = BRANCH_W
POOL_WINDOWS = (2, 4, 8, 16)
POOL_GROUPS = len(POOL_WINDOWS)
POOL_GW = POOL_W // POOL_GROUPS

SGU_W = BRANCH_W
SGU_HEADS = 8
SGU_HD = SGU_W // SGU_HEADS
CHUNK = 128

N_Q_HEADS = 16
N_KV_HEADS = 2
Q_PER_KV = N_Q_HEADS // N_KV_HEADS
HEAD_DIM = 64
ATTN_W = N_Q_HEADS * HEAD_DIM
KV_W = N_KV_HEADS * HEAD_DIM
WINDOW = 128
BLOCK = 128
NUM_BUCKETS = 32
MAX_DISTANCE = 128

CONV_W = BRANCH_W
CONV_K = 31

ALPHA = (2 * DEPTH) ** 0.25
BETA = (8 * DEPTH) ** -0.25
LN_EPS = 1e-5

IN_SPLITS = (POOL_W, POOL_W,
             SGU_W, SGU_W, SGU_W,
             ATTN_W, KV_W, KV_W, ATTN_W,
             2 * CONV_W, CONV_W,
             N_BRANCH * D_MODEL)
D_IN = sum(IN_SPLITS)
SPLIT_POINTS = [int(p) for p in np.cumsum(IN_SPLITS)[:-1]]

kernel_name = "hybrid_pool_sgu_swa_conv_gated_deepnorm"


def layer_norm(x, g, b):
    xf = x.astype(jnp.float32)
    mu = jnp.mean(xf, axis=-1, keepdims=True)
    var = jnp.mean(jnp.square(xf - mu), axis=-1, keepdims=True)
    y = (xf - mu) * lax.rsqrt(var + LN_EPS) * g.astype(jnp.float32) + b.astype(jnp.float32)
    return y.astype(x.dtype)


def t5_bucket(n):
    max_exact = NUM_BUCKETS // 2
    nf = jnp.maximum(n, 1).astype(jnp.float32)
    large = max_exact + (jnp.log(nf / max_exact) / math.log(MAX_DISTANCE / max_exact)
                         * (NUM_BUCKETS - max_exact)).astype(jnp.int32)
    large = jnp.minimum(large, NUM_BUCKETS - 1)
    return jnp.where(n < max_exact, n, large)


def band_geometry():
    i = jnp.arange(BLOCK)[:, None]
    j = jnp.arange(2 * BLOCK)[None, :]
    return i + BLOCK - j


def relative_band_bias(rel_bias):
    d = jnp.clip(band_geometry(), 0, WINDOW - 1)
    bias = rel_bias[t5_bucket(d)]
    bias = jnp.transpose(bias, (2, 0, 1)).astype(jnp.float32)
    return bias.reshape(N_KV_HEADS, Q_PER_KV, BLOCK, 2 * BLOCK)


def pool_mixer(xa, w_grp, scale):
    b, s, _ = xa.shape
    xg = xa.reshape(b, s, POOL_GROUPS, POOL_GW)
    cs = jnp.cumsum(xg.astype(jnp.float32), axis=1)
    cs_pad = jnp.concatenate([jnp.zeros_like(cs[:, :1]), cs], axis=1)
    t = jnp.arange(s)[:, None]
    win = jnp.array(POOL_WINDOWS, dtype=jnp.int32)[None, :]
    lo = jnp.maximum(t + 1 - win, 0)
    cnt = jnp.minimum(t + 1, win).astype(jnp.float32)
    gidx = jnp.arange(POOL_GROUPS)[None, :]
    window_sum = cs - cs_pad[:, lo, gidx, :]
    pooled = (window_sum / cnt[None, :, :, None]).astype(xa.dtype)
    mix = pooled - xg
    y = jnp.einsum('bsgc,gcd->bsgd', mix, w_grp).reshape(b, s, POOL_W)
    return y * scale


def spatial_gating(u, v, ln_g, ln_b, w_s, b_s):
    b, s, _ = v.shape
    nc = s // CHUNK
    vn = layer_norm(v, ln_g, ln_b).reshape(b, nc, CHUNK, SGU_HEADS, SGU_HD)
    causal = jnp.tril(jnp.ones((CHUNK, CHUNK), dtype=bool))
    w = jnp.where(causal[None], w_s, jnp.zeros_like(w_s))
    sp = jnp.einsum('hts,bnshd->bnthd', w, vn) + jnp.transpose(b_s)[None, None, :, :, None]
    return u * sp.reshape(b, s, SGU_W)


def sliding_window_attention(q, k, v, sinks, band_bias):
    b, s, _ = q.shape
    nb = s // BLOCK
    qb = q.reshape(b, nb, BLOCK, N_KV_HEADS, Q_PER_KV, HEAD_DIM)
    kb = k.reshape(b, nb, BLOCK, N_KV_HEADS, HEAD_DIM)
    vb = v.reshape(b, nb, BLOCK, N_KV_HEADS, HEAD_DIM)

    def band(t):
        prev = jnp.concatenate([jnp.zeros_like(t[:, :1]), t[:, :-1]], axis=1)
        return jnp.concatenate([prev, t], axis=2)

    k_band, v_band = band(kb), band(vb)
    logits = jnp.einsum('bnqhgd,bnkhd->bnhgqk', qb, k_band).astype(jnp.float32)
    logits = logits * (HEAD_DIM ** -0.5) + band_bias[None, None]
    d = band_geometry()
    in_window = (d >= 0) & (d < WINDOW)
    has_prev = (jnp.arange(nb)[:, None] > 0) | (jnp.arange(2 * BLOCK)[None, :] >= BLOCK)
    mask = in_window[None] & has_prev[:, None, :]
    logits = jnp.where(mask[None, :, None, None], logits, jnp.float32(-1e30))
    sink = jnp.broadcast_to(sinks.astype(jnp.float32).reshape(1, 1, N_KV_HEADS, Q_PER_KV, 1, 1),
                            logits.shape[:-1] + (1,))
    probs = jax.nn.softmax(jnp.concatenate([logits, sink], axis=-1), axis=-1)[..., :-1]
    o = jnp.einsum('bnhgqk,bnkhd->bnqhgd', probs.astype(v.dtype), v_band)
    return o.reshape(b, s, ATTN_W)


def conformer_conv(d_in, conv_w, conv_b, ln_g, ln_b):
    val, gate = jnp.split(d_in, 2, axis=-1)
    glu = val * jax.nn.sigmoid(gate)
    y = lax.conv_general_dilated(glu, conv_w[:, None, :], window_strides=(1,),
                                 padding=[(CONV_K - 1, 0)],
                                 dimension_numbers=('NWC', 'WIO', 'NWC'),
                                 feature_group_count=CONV_W) + conv_b
    return jax.nn.silu(layer_norm(y, ln_g, ln_b))


def setup_inputs(seed: int = 0) -> dict:
    key = jax.random.key(seed)
    ks = jax.random.split(key, 20)
    nrm = lambda k, shape: jax.random.normal(k, shape, dtype=jnp.float32)
    return {
        "x": nrm(ks[0], (BATCH, SEQ, D_MODEL)),
        "w_in": nrm(ks[1], (DEPTH, D_MODEL, D_IN)) * D_MODEL ** -0.5,
        "pool_w": nrm(ks[2], (DEPTH, POOL_GROUPS, POOL_GW, POOL_GW)) * POOL_GW ** -0.5,
        "pool_scale": 1.0 + 0.1 * nrm(ks[3], (DEPTH, POOL_W)),
        "sgu_ln_g": 1.0 + 0.1 * nrm(ks[4], (DEPTH, SGU_W)),
        "sgu_ln_b": 0.1 * nrm(ks[5], (DEPTH, SGU_W)),
        "sgu_w": nrm(ks[6], (DEPTH, SGU_HEADS, CHUNK, CHUNK)) * 0.5 * CHUNK ** -0.5,
        "sgu_b": 1.0 + 0.1 * nrm(ks[7], (DEPTH, SGU_HEADS, CHUNK)),
        "attn_sinks": 0.5 * nrm(ks[8], (DEPTH, N_Q_HEADS)),
        "rel_bias": 0.5 * nrm(ks[9], (NUM_BUCKETS, N_Q_HEADS)),
        "conv_w": nrm(ks[10], (DEPTH, CONV_K, CONV_W)) * CONV_K ** -0.5,
        "conv_b": 0.02 * nrm(ks[11], (DEPTH, CONV_W)),
        "conv_ln_g": 1.0 + 0.1 * nrm(ks[12], (DEPTH, CONV_W)),
        "conv_ln_b": 0.1 * nrm(ks[13], (DEPTH, CONV_W)),
        "w_branch": nrm(ks[14], (DEPTH, N_BRANCH, BRANCH_W, D_MODEL)) * BRANCH_W ** -0.5 * BETA,
        "w_out": nrm(ks[15], (DEPTH, D_MODEL, D_MODEL)) * D_MODEL ** -0.5 * BETA,
        "ln_g": 1.0 + 0.1 * nrm(ks[16], (DEPTH, D_MODEL)),
        "ln_b": 0.1 * nrm(ks[17], (DEPTH, D_MODEL)),
    }


def reference(x, w_in, pool_w, pool_scale, sgu_ln_g, sgu_ln_b, sgu_w, sgu_b, attn_sinks,
              rel_bias, conv_w, conv_b, conv_ln_g, conv_ln_b, w_branch, w_out, ln_g, ln_b):
    b, s, _ = x.shape
    band_bias = relative_band_bias(rel_bias)
    for l in range(DEPTH):
        h = jnp.einsum('bsd,de->bse', x, w_in[l])
        (a_in, a_gate, u, v, b_gate, q, k, vv, c_gate,
         d_in, d_gate, g_logits) = jnp.split(h, SPLIT_POINTS, axis=-1)

        y_a = pool_mixer(a_in, pool_w[l], pool_scale[l]) * jax.nn.silu(a_gate)
        y_b = spatial_gating(u, v, sgu_ln_g[l], sgu_ln_b[l], sgu_w[l], sgu_b[l]) * jax.nn.silu(b_gate)
        y_c = sliding_window_attention(q, k, vv, attn_sinks[l], band_bias) * jax.nn.silu(c_gate)
        y_d = conformer_conv(d_in, conv_w[l], conv_b[l], conv_ln_g[l], conv_ln_b[l]) * jax.nn.silu(d_gate)

        gates = jax.nn.sigmoid(g_logits.reshape(b, s, N_BRANCH, D_MODEL))
        branches = (y_a, y_b, y_c, y_d)
        merged = gates[:, :, 0] * jnp.einsum('bsc,cd->bsd', branches[0], w_branch[l, 0])
        for i in range(1, N_BRANCH):
            merged = merged + gates[:, :, i] * jnp.einsum('bsc,cd->bsd', branches[i], w_branch[l, i])
        out = jnp.einsum('bsd,de->bse', merged, w_out[l])
        x = layer_norm(ALPHA * x + out, ln_g[l], ln_b[l])
    return x
```

```cpp
#include <hip/hip_runtime.h>
#include <hip/hip_cooperative_groups.h>
#include <cstdio>
namespace cg = cooperative_groups;

#define LAS __attribute__((address_space(3)))
typedef unsigned short bf16_t;
typedef short bf16x8 __attribute__((ext_vector_type(8)));
typedef float f32x4 __attribute__((ext_vector_type(4)));
typedef float f32x2 __attribute__((ext_vector_type(2)));
typedef unsigned u32x4 __attribute__((ext_vector_type(4)));
typedef unsigned u32x2 __attribute__((ext_vector_type(2)));

#ifndef N_LAUNCH_MODE
#define N_LAUNCH_MODE 1
#endif

constexpr int SEQ = 16384, DM = 2048, DIN = 18688, NMIX = 10496  , HMW = 8448  , HGW = 8192, DEPTH = 2;
constexpr int C_AIN = 0, C_AGATE = 1024, C_UG = 2048, C_V = 3072, C_Q = 4096, C_K = 5120, C_VV = 5248, C_CGATE = 5376, C_GLU = 6400, C_DGATE = 7424;
constexpr float LN_EPS = 1e-5f;
constexpr float ALPHA = 1.4142135623730951f;

constexpr size_t SZ_WIN = (size_t)DIN * DM * 2;
constexpr size_t WS_WIN = 0;
constexpr size_t WS_WB = WS_WIN + 2 * SZ_WIN;
constexpr size_t WS_WO = WS_WB + (size_t)2 * 4 * 2048 * 1024 * 2;
constexpr size_t WS_WP = WS_WO + (size_t)2 * 2048 * 2048 * 2;
constexpr size_t WS_XB = WS_WP + (size_t)2 * 4 * 256 * 256 * 2;
constexpr size_t WS_HM = WS_XB + (size_t)SEQ * DM * 2;
constexpr size_t WS_HG = WS_HM + (size_t)SEQ * HMW * 2;
constexpr size_t WS_Y = WS_HG + (size_t)SEQ * HGW * 2;
constexpr size_t WS_MIX = WS_Y + (size_t)4 * SEQ * 1024 * 2;
constexpr size_t WS_END = WS_MIX + (size_t)4 * SEQ * 256 * 2;
constexpr size_t WS_CTL = WS_END, CTL_BYTES = 16384;
constexpr size_t WS_MACC = WS_HM;
constexpr size_t WS_MG = WS_HM + (size_t)SEQ * DM * 4;
static_assert(WS_MG + (size_t)SEQ * DM * 2 <= WS_HG, "alias map");

constexpr int LDS_BYTES = 147456;

struct Params {
    const float* in[18];
    float* out;
    unsigned char* ws;
    int ph_lo, ph_hi;
};

typedef const __attribute__((address_space(4))) Params* KP;
__device__ __forceinline__ KP kargs() { KP q = (KP)__builtin_amdgcn_kernarg_segment_ptr(); asm volatile("" : "+s"(q)); return q; }
#define OPAQUE_V(x) asm volatile("" : "+v"(x))
#define OPAQUE_S(x) asm volatile("" : "+s"(x))

__device__ __forceinline__ float bflo(unsigned w) { return __uint_as_float(w << 16); }
__device__ __forceinline__ float bfhi(unsigned w) { return __uint_as_float(w & 0xffff0000u); }
typedef __bf16 bf16v2_t __attribute__((ext_vector_type(2)));
__device__ __forceinline__ unsigned pk2(float lo, float hi) { bf16v2_t v; v[0] = (__bf16)lo; v[1] = (__bf16)hi; return __builtin_bit_cast(unsigned, v); }
__device__ __forceinline__ float sigmoidf_(float x) { return __builtin_amdgcn_rcpf(1.0f + __expf(-x)); }
__device__ __forceinline__ float siluf_(float x) { return x * sigmoidf_(x); }
__device__ __forceinline__ float wave_sum(float v) {
#pragma unroll
    for (int o = 1; o < 64; o <<= 1) v += __shfl_xor(v, o);
    return v;
}
__device__ __forceinline__ f32x4 mfma16(bf16x8 a, bf16x8 b, f32x4 c) { return __builtin_amdgcn_mfma_f32_16x16x32_bf16(a, b, c, 0, 0, 0); }

__constant__ unsigned char T5_BUCKET[128] = {0, 1, 2, 3, 4, 5, 6, 7, 8, 9, 10, 11, 12, 13, 14, 15, 16, 16, 16, 17, 17, 18, 18, 18, 19, 19, 19, 20, 20, 20, 20, 21, 21, 21, 21, 22, 22, 22, 22, 22, 23, 23, 23, 23, 23, 23, 24, 24, 24, 24, 24, 24, 25, 25, 25, 25, 25, 25, 25, 26, 26, 26, 26, 26, 26, 26, 26, 27, 27, 27, 27, 27, 27, 27, 27, 27, 27, 28, 28, 28, 28, 28, 28, 28, 28, 28, 28, 29, 29, 29, 29, 29, 29, 29, 29, 29, 29, 29, 29, 30, 30, 30, 30, 30, 30, 30, 30, 30, 30, 30, 30, 30, 30, 31, 31, 31, 31, 31, 31, 31, 31, 31, 31, 31, 31, 31, 31, 31};

namespace pg8 {
constexpr int BM = 256, BK = 64, HALF = 128, HTB = HALF * BK * 2, STAGE_BYTES = 8 * HTB, NXCD = 8, WGM = 3;
__device__ __forceinline__ int lds_byte(int r, int c) { const int st = (r >> 4) * 2 + (c >> 5), rr = r & 15, cc = c & 31, ob = rr * 64 + cc * 2; return st * 1024 + (ob ^ (((ob >> 9) & 1) << 5)); }
__device__ __forceinline__ void stage_rc(int b, int& R, int& C) { const int st = b / 1024, sb = b % 1024, swz = sb ^ (((sb >> 9) & 1) << 5); R = (st >> 1) * 16 + swz / 64; C = (st & 1) * 32 + (swz % 64) / 2; }
__device__ __forceinline__ int perm32(int rho) { const int n = rho >> 4, i = rho & 15; return 8 * (i >> 2) + 4 * n + (i & 3); }

struct Unit { int pm, pn; };
struct Gemm { const bf16_t* A; const bf16_t* Bt; int M, N, K; };

struct StaticOrder {
    int nM, nN, nwg, G, c, limit;
    __device__ void init(int M, int N, int G_, int c_) { nM = M / BM; nN = N / BM; nwg = nM * nN; G = G_; c = c_; limit = nwg; }
    __device__ bool next(int i, Unit& u) const {
        const long L = (long)i * G + c; if (L >= limit) return false;
        int wgid = (int)L; { const int q = nwg / NXCD, r = nwg % NXCD, xcd = wgid % NXCD, off = wgid / NXCD; wgid = (xcd < r ? xcd * (q + 1) : r * (q + 1) + (xcd - r) * q) + off; }
        const int nig = WGM * nN, gid = wgid / nig, fm = gid * WGM, gsz = (nM - fm) < WGM ? (nM - fm) : WGM;
        u.pm = fm + ((wgid % nig) % gsz); u.pn = (wgid % nig) / gsz; return true;
    }
};
struct ExtraOrder {
    int pm, pn;
    __device__ bool next(int i, Unit& u) const { if (i != 0) return false; u.pm = pm; u.pn = pn; return true; }
};
struct PoolOrder {
    int G, c;
    __device__ bool next(int i, Unit& u) const { const int L = i * G + c; if (L >= 256) return false; u.pm = L; u.pn = L >> 6; return true; }
};
struct BrOrder {
    StaticOrder so;
    __device__ bool next(int i, Unit& u) const { Unit t; if (!so.next(i >> 2, t)) return false; const int b = i & 3; u.pm = b * 64 + t.pm; u.pn = b * 8 + t.pn; return true; }
};

template <bool ALIGN_EPI, bool SP2, class Epi, class Sched>
__device__ __forceinline__ void gemm_phase(LAS unsigned char* lds, const Gemm g, const Sched& S, const Epi& E) {
    int tid_ = threadIdx.x; OPAQUE_V(tid_); int K_ = g.K; OPAQUE_S(K_);
    const int tid = tid_, wid = __builtin_amdgcn_readfirstlane(tid >> 6), lane = tid & 63, wr = wid >> 2, wc = wid & 3, fr = lane & 15, fq = lane >> 4;
    const int K = K_, nt = K / BK;
    unsigned voffA[2], voffB[2];
#pragma unroll
    for (int i = 0; i < 2; ++i) { int R, C; stage_rc(tid * 16 + i * 8192, R, C); const int Rb = Epi::PERM ? ((R & ~31) + perm32(R & 31)) : R;
        voffA[i] = (unsigned)(R * K + C) * 2u; voffB[i] = (unsigned)(Rb * K + C) * 2u; }
    const size_t kstep = (size_t)(BK * 2);
    const size_t hstep = (size_t)HALF * K * 2;
    const size_t tstep = 2 * hstep;
    const unsigned ldsw = (unsigned)wid * 1024u;
    const int aoff = lds_byte(wr * 64 + fr, fq * 8), boff = lds_byte(wc * 32 + fr, fq * 8);
#define PG8_SA(b, h) (((b) * 2 + (h)) * HTB)
#define PG8_SB(b, h) ((4 + (b) * 2 + (h)) * HTB)
#define PG8_STAGE(bufoff, gbase, voff) do { _Pragma("unroll") for (int _i = 0; _i < 2; ++_i) \
        __builtin_amdgcn_global_load_lds((const unsigned*)((const char*)(gbase) + (voff)[_i]), (LAS unsigned*)(lds + (bufoff) + ldsw + _i * 8192), 16, 0, 0); } while (0)
#define PG8_LDA(dst, b, h) do { _Pragma("unroll") for (int m = 0; m < 4; ++m) _Pragma("unroll") for (int k = 0; k < 2; ++k) dst[m][k] = *(const LAS bf16x8*)(lds + PG8_SA(b, h) + aoff + m * 2048 + k * 1024); } while (0)
#define PG8_LDB(dst, b, h) do { _Pragma("unroll") for (int n = 0; n < 2; ++n) _Pragma("unroll") for (int k = 0; k < 2; ++k) dst[n][k] = *(const LAS bf16x8*)(lds + PG8_SB(b, h) + boff + n * 2048 + k * 1024); } while (0)
#define PG8_MMA(ai, bj, At, Bt) do { __builtin_amdgcn_s_setprio(1); _Pragma("unroll") for (int m = 0; m < 4; ++m) _Pragma("unroll") for (int n = 0; n < 2; ++n) _Pragma("unroll") for (int k = 0; k < 2; ++k) \
        acc[ai][bj][m][n] = __builtin_amdgcn_mfma_f32_16x16x32_bf16(Bt[n][k], At[m][k], acc[ai][bj][m][n], 0, 0, 0); __builtin_amdgcn_s_setprio(0); } while (0)
#define PG8_WAIT_V(n) asm volatile("s_waitcnt vmcnt(" #n ")" ::: "memory")
#define PG8_WAIT_L(n) asm volatile("s_waitcnt lgkmcnt(" #n ")" ::: "memory")
#define PG8_BAR __builtin_amdgcn_s_barrier()
#define PG8_SCHED __builtin_amdgcn_sched_barrier(0)
    Unit cur, nxt; int ui = 0;
    if (!S.next(0, cur)) return;
    f32x4 acc[2][2][4][2];
#pragma unroll
    for (int a = 0; a < 2; ++a)
#pragma unroll
        for (int b = 0; b < 2; ++b)
#pragma unroll
            for (int m = 0; m < 4; ++m)
#pragma unroll
                for (int n = 0; n < 2; ++n) acc[a][b][m][n] = (f32x4){0.f, 0.f, 0.f, 0.f};
    bf16x8 At[4][2], B0[2][2], B1[2][2];
    const char* cA = (const char*)g.A + (size_t)cur.pm * tstep; const char* cB = (const char*)g.Bt + (size_t)cur.pn * tstep;
    if constexpr (SP2) {
        PG8_STAGE(PG8_SB(0, 0), cB, voffB); PG8_STAGE(PG8_SB(0, 1), cB + hstep, voffB); PG8_STAGE(PG8_SA(0, 0), cA, voffA); PG8_STAGE(PG8_SA(0, 1), cA + hstep, voffA);
        if (wr == 1) PG8_BAR;
        PG8_WAIT_V(2); PG8_BAR;
        PG8_STAGE(PG8_SB(1, 0), cB + kstep, voffB); PG8_STAGE(PG8_SA(1, 0), cA + kstep, voffA); PG8_STAGE(PG8_SB(1, 1), cB + hstep + kstep, voffB);
        PG8_WAIT_V(6); PG8_BAR;
    } else {
        PG8_STAGE(PG8_SB(0, 0), cB, voffB); PG8_STAGE(PG8_SA(0, 0), cA, voffA); PG8_STAGE(PG8_SB(0, 1), cB + hstep, voffB); PG8_STAGE(PG8_SA(0, 1), cA + hstep, voffA);
        if (wr == 1) PG8_BAR;
        PG8_WAIT_V(4); PG8_BAR;
        PG8_STAGE(PG8_SB(1, 0), cB + kstep, voffB); PG8_STAGE(PG8_SA(1, 0), cA + kstep, voffA); PG8_STAGE(PG8_SB(1, 1), cB + hstep + kstep, voffB);
        PG8_WAIT_V(6); PG8_BAR;
    }
    for (;;) {
        const bool has_next = S.next(ui + 1, nxt);
        const char* nA = has_next ? (const char*)g.A + (size_t)nxt.pm * tstep : cA; const char* nB = has_next ? (const char*)g.Bt + (size_t)nxt.pn * tstep : cB;
        for (int t = 0; t < nt; t += 2) {
            const bool last = (t == nt - 2);
            const char* a1 = cA + (size_t)(t + 1) * kstep;
            const char* a2 = last ? nA : cA + (size_t)(t + 2) * kstep; const char* b2 = last ? nB : cB + (size_t)(t + 2) * kstep;
            const char* a3 = a2 + kstep; const char* b3 = b2 + kstep;
            if constexpr (SP2) {
            PG8_LDB(B0, 0, 0); PG8_LDB(B1, 0, 1); PG8_SCHED; PG8_LDA(At, 0, 0); PG8_STAGE(PG8_SA(1, 1), a1 + hstep, voffA);
            PG8_WAIT_V(8); PG8_WAIT_L(0); PG8_BAR; PG8_MMA(0, 0, At, B0); PG8_MMA(0, 1, At, B1); PG8_BAR; PG8_SCHED;
            PG8_LDA(At, 0, 1); PG8_STAGE(PG8_SB(0, 0), b2, voffB); PG8_STAGE(PG8_SB(0, 1), b2 + hstep, voffB); PG8_STAGE(PG8_SA(0, 0), a2, voffA);
            PG8_WAIT_V(8); PG8_WAIT_L(0); PG8_BAR; PG8_MMA(1, 0, At, B0); PG8_MMA(1, 1, At, B1); PG8_BAR; PG8_SCHED;
            PG8_LDB(B0, 1, 0); PG8_LDB(B1, 1, 1); PG8_SCHED; PG8_LDA(At, 1, 0); PG8_STAGE(PG8_SA(0, 1), a2 + hstep, voffA);
            PG8_WAIT_V(8); PG8_WAIT_L(0); PG8_BAR; PG8_MMA(0, 0, At, B0); PG8_MMA(0, 1, At, B1); PG8_BAR; PG8_SCHED;
            PG8_LDA(At, 1, 1); PG8_STAGE(PG8_SB(1, 0), b3, voffB); PG8_STAGE(PG8_SB(1, 1), b3 + hstep, voffB); PG8_STAGE(PG8_SA(1, 0), a3, voffA);
            PG8_WAIT_V(8); PG8_WAIT_L(0); PG8_BAR; PG8_MMA(1, 0, At, B0); PG8_MMA(1, 1, At, B1); PG8_BAR; PG8_SCHED;
            } else {
            PG8_LDB(B0, 0, 0); PG8_SCHED; PG8_LDA(At, 0, 0); PG8_STAGE(PG8_SA(1, 1), a1 + hstep, voffA);
            PG8_WAIT_L(8); PG8_BAR; PG8_WAIT_L(0); PG8_MMA(0, 0, At, B0); PG8_BAR; PG8_SCHED;
            PG8_LDB(B1, 0, 1); PG8_STAGE(PG8_SB(0, 0), b2, voffB);
            PG8_BAR; PG8_WAIT_L(0); PG8_MMA(0, 1, At, B1); PG8_BAR;
            PG8_LDA(At, 0, 1); PG8_STAGE(PG8_SA(0, 0), a2, voffA);
            PG8_BAR; PG8_WAIT_L(0); PG8_MMA(1, 0, At, B0); PG8_BAR; PG8_SCHED;
            PG8_STAGE(PG8_SB(0, 1), b2 + hstep, voffB);
            PG8_WAIT_V(6); PG8_BAR; PG8_MMA(1, 1, At, B1); PG8_BAR;
            PG8_LDB(B0, 1, 0); PG8_SCHED; PG8_LDA(At, 1, 0); PG8_STAGE(PG8_SA(0, 1), a2 + hstep, voffA);
            PG8_WAIT_L(8); PG8_BAR; PG8_WAIT_L(0); PG8_MMA(0, 0, At, B0); PG8_BAR; PG8_SCHED;
            PG8_LDB(B1, 1, 1); PG8_STAGE(PG8_SB(1, 0), b3, voffB);
            PG8_BAR; PG8_WAIT_L(0); PG8_MMA(0, 1, At, B1); PG8_BAR;
            PG8_LDA(At, 1, 1); PG8_STAGE(PG8_SA(1, 0), a3, voffA);
            PG8_BAR; PG8_WAIT_L(0); PG8_MMA(1, 0, At, B0); PG8_BAR; PG8_SCHED;
            PG8_STAGE(PG8_SB(1, 1), b3 + hstep, voffB);
            PG8_WAIT_V(6); PG8_BAR; PG8_MMA(1, 1, At, B1); PG8_BAR;
            }
        }
        if constexpr (ALIGN_EPI) { if (wr == 0) PG8_BAR; }
        E(acc, cur, wr, wc, fr, fq);
        if (!has_next) break;
        if (E.zero_after(cur))
#pragma unroll
        for (int a = 0; a < 2; ++a)
#pragma unroll
            for (int b = 0; b < 2; ++b)
#pragma unroll
                for (int m = 0; m < 4; ++m)
#pragma unroll
                    for (int n = 0; n < 2; ++n) acc[a][b][m][n] = (f32x4){0.f, 0.f, 0.f, 0.f};
        cur = nxt; cA = nA; cB = nB; ++ui;
        if constexpr (ALIGN_EPI) { if (wr == 1) PG8_BAR; }
    }
    PG8_WAIT_V(0);
    if constexpr (!ALIGN_EPI) { if (wr == 0) PG8_BAR; }
    PG8_BAR;
#undef PG8_SA
#undef PG8_SB
#undef PG8_STAGE
#undef PG8_LDA
#undef PG8_LDB
#undef PG8_MMA
#undef PG8_WAIT_V
#undef PG8_WAIT_L
#undef PG8_BAR
#undef PG8_SCHED
}

struct EpiH {
    static constexpr bool PERM = true, PROBE2X = true;
    bf16_t* HM; bf16_t* HG;
    __device__ __forceinline__ bool zero_after(const Unit&) const { return true; }
    __device__ __forceinline__ void operator()(f32x4 (&acc)[2][2][4][2], const Unit& u, int wr, int wc, int fr, int fq) const {
        const int pn = u.pn;
        int act = 0; float scale = 1.f; int colt;
        if (pn < 8) { colt = pn * 256; if (pn >= 4) act = 1; }
        else if (pn < 16) { colt = C_UG + (pn - 8) * 128; act = 3; }
        else if (pn < 20) colt = C_V + (pn - 16) * 256;
        else if (pn < 24) { colt = C_Q + (pn - 20) * 256; scale = 0.125f; }
        else if (pn < 25) colt = C_K;
        else if (pn < 29) { colt = C_CGATE + (pn - 25) * 256; act = 1; }
        else if (pn < 37) { colt = C_GLU + (pn - 29) * 128; act = 4; }
        else { colt = C_DGATE + (pn - 37) * 256; act = 1; }
        if (pn >= 41) {
            const int row0 = u.pm * BM + wr * 64 + fr, d0 = (pn - 41) * 64 + wc * 16 + 4 * fq;
#pragma unroll
            for (int ai = 0; ai < 2; ++ai)
#pragma unroll
                for (int m = 0; m < 4; ++m) { bf16_t* rowp = HG + (size_t)(row0 + ai * HALF + m * 16) * HGW + d0;
                    u32x2 w[4];
#pragma unroll
                    for (int jp = 0; jp < 2; ++jp) { float r[2][4];
#pragma unroll
                        for (int jj = 0; jj < 2; ++jj) { const int j = 2 * jp + jj; float e[4];
#pragma unroll
                            for (int i = 0; i < 4; ++i) e[i] = 1.0f + __expf(-fminf(fmaxf(acc[ai][i >> 1][m][i & 1][j], -30.f), 30.f));
                            r[jj][0] = e[1] * __builtin_amdgcn_rcpf(e[0]); r[jj][1] = e[2] * __builtin_amdgcn_rcpf(e[1]); r[jj][2] = e[3] * __builtin_amdgcn_rcpf(e[2]); r[jj][3] = __builtin_amdgcn_rcpf(e[3]); }
#pragma unroll
                        for (int k = 0; k < 4; ++k) { const unsigned pk = pk2(r[0][k], r[1][k]); if (jp == 0) w[k].x = pk; else w[k].y = pk; } }
#pragma unroll
                    for (int k = 0; k < 4; ++k) *(u32x2*)(rowp + k * 2048) = w[k];
                    asm volatile("" ::: "memory"); }
            return;
        }
        bf16_t* base = HM; const int ldc = HMW;
        if (act >= 3) {
            const int row0 = u.pm * BM + wr * 64 + fr, col0 = colt + wc * 32 + 8 * fq;
#pragma unroll
            for (int ai = 0; ai < 2; ++ai)
#pragma unroll
                for (int m = 0; m < 4; ++m) { bf16_t* rowp = base + (size_t)(row0 + ai * HALF + m * 16) * ldc + col0;
                    f32x4 v0 = acc[ai][0][m][0], v1 = acc[ai][0][m][1]; const f32x4 g0 = acc[ai][1][m][0], g1 = acc[ai][1][m][1];
#pragma unroll
                    for (int j = 0; j < 4; ++j) { const float s0 = sigmoidf_(g0[j]), s1 = sigmoidf_(g1[j]);
                        v0[j] *= (act == 3) ? g0[j] * s0 : s0; v1[j] *= (act == 3) ? g1[j] * s1 : s1; }
                    u32x4 w; w.x = pk2(v0[0], v0[1]); w.y = pk2(v0[2], v0[3]); w.z = pk2(v1[0], v1[1]); w.w = pk2(v1[2], v1[3]);
                    *(u32x4*)rowp = w; }
            return;
        }
        const int row0 = u.pm * BM + wr * 64 + fr, col0 = colt + wc * 32 + 8 * fq;
#pragma unroll
        for (int ai = 0; ai < 2; ++ai)
#pragma unroll
            for (int m = 0; m < 4; ++m) { bf16_t* rowp = base + (size_t)(row0 + ai * HALF + m * 16) * ldc + col0;
#pragma unroll
                for (int bj = 0; bj < 2; ++bj) { f32x4 v0 = acc[ai][bj][m][0] * scale, v1 = acc[ai][bj][m][1] * scale;
                    if (act == 1) {
#pragma unroll
                        for (int j = 0; j < 4; ++j) { v0[j] = siluf_(v0[j]); v1[j] = siluf_(v1[j]); } }
                    u32x4 w; w.x = pk2(v0[0], v0[1]); w.y = pk2(v0[2], v0[3]); w.z = pk2(v1[0], v1[1]); w.w = pk2(v1[2], v1[3]);
                    *(u32x4*)(rowp + bj * HALF) = w; } }
    }
};
struct EpiPool {
    static constexpr bool PERM = true, PROBE2X = false;
    const bf16_t* HM; bf16_t* YA;
    __device__ __forceinline__ bool zero_after(const Unit&) const { return true; }
    __device__ __forceinline__ void operator()(f32x4 (&acc)[2][2][4][2], const Unit& u, int wr, int wc, int fr, int fq) const {
        const int g = u.pm >> 6; const int row0 = (u.pm & 63) * BM + wr * 64 + fr, col0 = g * 256 + wc * 32 + 8 * fq;
#pragma unroll
        for (int ai = 0; ai < 2; ++ai)
#pragma unroll
            for (int m = 0; m < 4; ++m) { const size_t row = (size_t)(row0 + ai * HALF + m * 16);
#pragma unroll
                for (int bj = 0; bj < 2; ++bj) { const int col = col0 + bj * HALF;
                    const u32x4 gt = *(const u32x4*)(HM + row * HMW + C_AGATE + col);
                    const f32x4 v0 = acc[ai][bj][m][0], v1 = acc[ai][bj][m][1];
                    u32x4 w; w.x = pk2(v0[0] * bflo(gt.x), v0[1] * bfhi(gt.x)); w.y = pk2(v0[2] * bflo(gt.y), v0[3] * bfhi(gt.y));
                    w.z = pk2(v1[0] * bflo(gt.z), v1[1] * bfhi(gt.z)); w.w = pk2(v1[2] * bflo(gt.w), v1[3] * bfhi(gt.w));
                    *(u32x4*)(YA + row * 1024 + col) = w; } }
    }
};
struct EpiBr {
    static constexpr bool PERM = true, PROBE2X = false;
    const bf16_t* HG; bf16_t* MG;
    __device__ __forceinline__ bool zero_after(const Unit& u) const { return (u.pm >> 6) == 3; }
    __device__ __forceinline__ void operator()(f32x4 (&acc)[2][2][4][2], const Unit& u, int wr, int wc, int fr, int fq) const {
        const int br = u.pm >> 6; const int row0 = (u.pm & 63) * BM + wr * 64 + fr, col0 = (u.pn & 7) * BM + wc * 32 + 8 * fq;
#pragma unroll
        for (int ai = 0; ai < 2; ++ai)
#pragma unroll
            for (int m = 0; m < 4; ++m) { const size_t row = (size_t)(row0 + ai * HALF + m * 16);
#pragma unroll
                for (int bj = 0; bj < 2; ++bj) { const int col = col0 + bj * HALF;
                    const u32x4 gt = *(const u32x4*)(HG + row * HGW + br * 2048 + col);
                    f32x4 v0 = acc[ai][bj][m][0], v1 = acc[ai][bj][m][1];
                    v0[0] *= bflo(gt.x); v0[1] *= bfhi(gt.x); v0[2] *= bflo(gt.y); v0[3] *= bfhi(gt.y);
                    v1[0] *= bflo(gt.z); v1[1] *= bfhi(gt.z); v1[2] *= bflo(gt.w); v1[3] *= bfhi(gt.w);
                    if (br < 3) { acc[ai][bj][m][0] = v0; acc[ai][bj][m][1] = v1; }
                    else { u32x4 w; w.x = pk2(v0[0], v0[1]); w.y = pk2(v0[2], v0[3]); w.z = pk2(v1[0], v1[1]); w.w = pk2(v1[2], v1[3]); *(u32x4*)(MG + row * DM + col) = w; } } }
    }
};
struct EpiOut {
    static constexpr bool PERM = false, PROBE2X = false;
    const float* xres; float* out;
    __device__ __forceinline__ bool zero_after(const Unit&) const { return true; }
    __device__ __forceinline__ void operator()(f32x4 (&acc)[2][2][4][2], const Unit& u, int wr, int wc, int fr, int fq) const {
        const int row0 = u.pm * BM + wr * 64 + fr, col0 = u.pn * BM + wc * 32 + 4 * fq;
#pragma unroll
        for (int ai = 0; ai < 2; ++ai)
#pragma unroll
            for (int m = 0; m < 4; ++m) { const size_t ro = (size_t)(row0 + ai * HALF + m * 16) * DM + col0;
#pragma unroll
                for (int bj = 0; bj < 2; ++bj)
#pragma unroll
                    for (int n = 0; n < 2; ++n) { const f32x4 xr = *(const f32x4*)(xres + ro + bj * HALF + n * 16);
                        *(f32x4*)(out + ro + bj * HALF + n * 16) = xr * ALPHA + acc[ai][bj][m][n]; } }
    }
};
}

__device__ __forceinline__ void p0_transpose_item(const float* W, int K, int N, bf16_t* WT, LAS float* scr, int item, int lane, const float* nscale = nullptr, bool gate_remap = false) {
    const int nblk = N / 32, kb = item / nblk, nb = item % nblk, k0 = 64 * kb, n0 = 32 * nb;
#pragma unroll 8
    for (int i = 0; i < 32; ++i) { const int kk = 2 * i + (lane >> 5); scr[kk * 33 + (lane & 31)] = W[(size_t)(k0 + kk) * N + n0 + (lane & 31)]; }
    asm volatile("s_waitcnt lgkmcnt(0)" ::: "memory");
    const int c = lane & 7;
#pragma unroll
    for (int j = 0; j < 4; ++j) { const int n = (lane >> 3) + 8 * j; const LAS float* s = scr + (8 * c) * 33 + n;
        const float sc = nscale ? nscale[n0 + n] : 1.0f;
        u32x4 o; o.x = pk2(s[0 * 33] * sc, s[1 * 33] * sc); o.y = pk2(s[2 * 33] * sc, s[3 * 33] * sc); o.z = pk2(s[4 * 33] * sc, s[5 * 33] * sc); o.w = pk2(s[6 * 33] * sc, s[7 * 33] * sc);
        int orow = n0 + n;
        if (gate_remap) {
            const int n_ = orow;
            if (n_ >= NMIX) { const int g = n_ - NMIX, i = g >> 11, d = g & 2047, dl = d & 63;
                orow = NMIX + (d >> 6) * 256 + 128 * (i >> 1) + 32 * (dl >> 4) + 8 * ((dl >> 2) & 3) + 4 * (i & 1) + (dl & 3); }
            else if (n_ >= 2048 && n_ < 3072) { const int ch = n_ - 2048; orow = (8 + (ch >> 7)) * 256 + (ch & 127); }
            else if (n_ >= 3072 && n_ < 4096) orow = 16 * 256 + (n_ - 3072);
            else if (n_ >= 4096 && n_ < 5120) { const int ch = n_ - 4096; orow = (8 + (ch >> 7)) * 256 + 128 + (ch & 127); }
            else if (n_ >= 7424 && n_ < 8448) { const int ch = n_ - 7424; orow = (29 + (ch >> 7)) * 256 + (ch & 127); }
            else if (n_ >= 8448 && n_ < 9472) { const int ch = n_ - 8448; orow = (29 + (ch >> 7)) * 256 + 128 + (ch & 127); } }
        *(u32x4*)(WT + (size_t)orow * K + k0 + 8 * c) = o; }
    asm volatile("s_waitcnt lgkmcnt(0)" ::: "memory");
}
__device__ __forceinline__ void phase_p0(KP p, LAS unsigned char* lds) {
    int tid_ = threadIdx.x; OPAQUE_V(tid_); const int tid = tid_, wid = tid >> 6, lane = tid & 63;
    LAS float* scr = (LAS float*)(lds + wid * 16384);
    const int gw = blockIdx.x * 8 + wid, NGW = gridDim.x * 8;
    constexpr int I_IN = 32 * 584, I_BR = 16 * 64, I_OUT = 32 * 64, I_PW = 4 * 8, PER_L = I_IN + 4 * I_BR + I_OUT + 4 * I_PW;
    for (int it = gw; it < 2 * PER_L; it += NGW) {
        const int l = it / PER_L; int r = it % PER_L;
        if (r < I_IN) { p0_transpose_item(p->in[1] + (size_t)l * DM * DIN, DM, DIN, (bf16_t*)(p->ws + WS_WIN + l * SZ_WIN), scr, r, lane, nullptr, true); continue; } r -= I_IN;
        if (r < 4 * I_BR) { const int i = r / I_BR; p0_transpose_item(p->in[14] + (size_t)(l * 4 + i) * 1024 * 2048, 1024, 2048, (bf16_t*)(p->ws + WS_WB) + (size_t)(l * 4 + i) * 2048 * 1024, scr, r % I_BR, lane); continue; } r -= 4 * I_BR;
        if (r < I_OUT) { p0_transpose_item(p->in[15] + (size_t)l * 2048 * 2048, 2048, 2048, (bf16_t*)(p->ws + WS_WO) + (size_t)l * 2048 * 2048, scr, r, lane); continue; } r -= I_OUT;
        { const int g = r / I_PW; p0_transpose_item(p->in[2] + (size_t)(l * 4 + g) * 256 * 256, 256, 256, (bf16_t*)(p->ws + WS_WP) + (size_t)(l * 4 + g) * 256 * 256, scr, r % I_PW, lane, p->in[3] + l * 1024 + g * 256); }
    }
    const float* x = p->in[0]; bf16_t* xb = (bf16_t*)(p->ws + WS_XB);
    const size_t n8 = (size_t)SEQ * DM / 8;
    for (size_t i = (size_t)blockIdx.x * 512 + tid; i < n8; i += (size_t)gridDim.x * 512) {
        const f32x4 a = *(const f32x4*)(x + i * 8), b = *(const f32x4*)(x + i * 8 + 4);
        u32x4 w; w.x = pk2(a[0], a[1]); w.y = pk2(a[2], a[3]); w.z = pk2(b[0], b[1]); w.w = pk2(b[2], b[3]);
        *(u32x4*)(xb + i * 8) = w;
    }
    __syncthreads();
}

__device__ __forceinline__ void attn_item(KP p, LAS unsigned char* lds, int l, int n, int hk) {
    int tid_ = threadIdx.x; OPAQUE_V(tid_);
    const int tid = tid_, wid = __builtin_amdgcn_readfirstlane(tid >> 6), lane = tid & 63, fr = lane & 15, fq = lane >> 4;
    const bf16_t* HM = (const bf16_t*)(p->ws + WS_HM);
    bf16_t* YC = (bf16_t*)(p->ws + WS_Y) + (size_t)2 * SEQ * 1024;
    LAS bf16_t* Ks = (LAS bf16_t*)lds;
    LAS unsigned* Vt32 = (LAS unsigned*)(lds + 36864);
    LAS float* bias = (LAS float*)(lds + 36864 + 35840);
    const int tokb = (n - 1) * 128;
    for (int idx = tid; idx < 2048; idx += 512) { const int key = idx >> 3, pc = idx & 7; const int tok = tokb + key;
        u32x4 v = (u32x4){0u, 0u, 0u, 0u}; if (tok >= 0) v = *(const u32x4*)(HM + (size_t)tok * HMW + C_K + hk * 64 + pc * 8);
        *(LAS u32x4*)(Ks + key * 72 + pc * 8) = v; }
    for (int idx = tid; idx < 1024; idx += 512) { const int p2 = idx & 127, dg = idx >> 7; const int tok0 = tokb + 2 * p2;
        u32x4 a = (u32x4){0u, 0u, 0u, 0u}, b = a;
        if (tok0 >= 0) { a = *(const u32x4*)(HM + (size_t)tok0 * HMW + C_VV + hk * 64 + dg * 8); b = *(const u32x4*)(HM + (size_t)(tok0 + 1) * HMW + C_VV + hk * 64 + dg * 8); }
        LAS unsigned* o = Vt32 + (dg * 8) * 140 + p2;
        o[0 * 140] = (a.x & 0xffffu) | (b.x << 16); o[1 * 140] = (a.x >> 16) | (b.x & 0xffff0000u);
        o[2 * 140] = (a.y & 0xffffu) | (b.y << 16); o[3 * 140] = (a.y >> 16) | (b.y & 0xffff0000u);
        o[4 * 140] = (a.z & 0xffffu) | (b.z << 16); o[5 * 140] = (a.z >> 16) | (b.z & 0xffff0000u);
        o[6 * 140] = (a.w & 0xffffu) | (b.w << 16); o[7 * 140] = (a.w >> 16) | (b.w & 0xffff0000u); }
    for (int idx = tid; idx < 768; idx += 512) Vt32[(idx / 12) * 140 + 128 + (idx % 12)] = 0u;
    for (int idx = tid; idx < 1024; idx += 512) { const int w = idx >> 7, d = idx & 127; bias[idx] = p->in[9][(int)T5_BUCKET[d] * 16 + hk * 8 + w]; }
    __syncthreads();
    const int h = hk * 8 + wid;
    const float sink = p->in[8][l * 16 + h];
    const LAS float* bh = bias + wid * 128;
    bf16x8 qn0, qn1;
    { const bf16_t* qrow = HM + (size_t)(n * 128 + fr) * HMW + C_Q + h * 64 + fq * 8; qn0 = *(const bf16x8*)qrow; qn1 = *(const bf16x8*)(qrow + 32); }
#pragma unroll 1
    for (int qt = 0; qt < 8; ++qt) {
        const int tok = n * 128 + qt * 16 + fr;
        const bf16x8 q0 = qn0, q1 = qn1;
        { const int tokn = n * 128 + (qt < 7 ? qt + 1 : qt) * 16 + fr; const bf16_t* qrow = HM + (size_t)tokn * HMW + C_Q + h * 64 + fq * 8; qn0 = *(const bf16x8*)qrow; qn1 = *(const bf16x8*)(qrow + 32); }
        u32x2 cg4[4];
#pragma unroll
        for (int dt = 0; dt < 4; ++dt) cg4[dt] = *(const u32x2*)(HM + (size_t)tok * HMW + C_CGATE + h * 64 + dt * 16 + fq * 4);
        f32x4 s[10];
#pragma unroll
        for (int k9 = 0; k9 < 9; ++k9) { const LAS bf16_t* kp = Ks + ((qt + k9) * 16 + fr) * 72 + fq * 8;
            f32x4 z = (f32x4){0.f, 0.f, 0.f, 0.f};
            z = mfma16(*(const LAS bf16x8*)kp, q0, z); z = mfma16(*(const LAS bf16x8*)(kp + 32), q1, z); s[k9] = z; }
        s[9] = (f32x4){0.f, 0.f, 0.f, 0.f};
        float mx = sink;
#pragma unroll
        for (int k9 = 0; k9 < 9; ++k9)
#pragma unroll
            for (int j = 0; j < 4; ++j) { const int dist = 128 - 16 * k9 + fr - fq * 4 - j; const int key = (qt + k9) * 16 + fq * 4 + j;
                const bool valid = (dist >= 0) && (dist < 128) && (n > 0 || key >= 128);
                const float lg = valid ? s[k9][j] + bh[dist & 127] : -1e30f; s[k9][j] = lg; mx = fmaxf(mx, lg); }
        mx = fmaxf(mx, __shfl_xor(mx, 16)); mx = fmaxf(mx, __shfl_xor(mx, 32));
        float sum = 0.f;
#pragma unroll
        for (int k9 = 0; k9 < 9; ++k9)
#pragma unroll
            for (int j = 0; j < 4; ++j) { const float e = __expf(s[k9][j] - mx); s[k9][j] = e; sum += e; }
        sum += __shfl_xor(sum, 16); sum += __shfl_xor(sum, 32); sum += __expf(sink - mx);
        const float inv = 1.0f / sum;
        f32x4 o[4];
#pragma unroll
        for (int dt = 0; dt < 4; ++dt) o[dt] = (f32x4){0.f, 0.f, 0.f, 0.f};
#pragma unroll
        for (int pr = 0; pr < 5; ++pr) {
            u32x4 pw; pw.x = pk2(s[2 * pr][0], s[2 * pr][1]); pw.y = pk2(s[2 * pr][2], s[2 * pr][3]); pw.z = pk2(s[2 * pr + 1][0], s[2 * pr + 1][1]); pw.w = pk2(s[2 * pr + 1][2], s[2 * pr + 1][3]);
            const bf16x8 pf = __builtin_bit_cast(bf16x8, pw);
#pragma unroll
            for (int dt = 0; dt < 4; ++dt) { const LAS unsigned* vp = Vt32 + (dt * 16 + fr) * 140 + (qt + 2 * pr) * 8 + fq * 2;
                const u32x2 lo = *(const LAS u32x2*)vp, hi = *(const LAS u32x2*)(vp + 8);
                u32x4 aw; aw.x = lo.x; aw.y = lo.y; aw.z = hi.x; aw.w = hi.y;
                o[dt] = mfma16(__builtin_bit_cast(bf16x8, aw), pf, o[dt]); } }
#pragma unroll
        for (int dt = 0; dt < 4; ++dt) { const int col = h * 64 + dt * 16 + fq * 4;
            const u32x2 gt = cg4[dt];
            u32x2 w; w.x = pk2(o[dt][0] * inv * bflo(gt.x), o[dt][1] * inv * bfhi(gt.x)); w.y = pk2(o[dt][2] * inv * bflo(gt.y), o[dt][3] * inv * bfhi(gt.y));
            *(u32x2*)(YC + (size_t)tok * 1024 + col) = w; }
    }
    __syncthreads();
}

__device__ __forceinline__ void sgu_item(KP p, LAS unsigned char* lds, int l, int n, int r) {
    int tid_ = threadIdx.x; OPAQUE_V(tid_);
    const int tid = tid_, wid = __builtin_amdgcn_readfirstlane(tid >> 6), lane = tid & 63, fr = lane & 15, fq = lane >> 4;
    const bf16_t* HM = (const bf16_t*)(p->ws + WS_HM);
    bf16_t* YB = (bf16_t*)(p->ws + WS_Y) + (size_t)1 * SEQ * 1024;
    LAS bf16_t* vnT = (LAS bf16_t*)lds;
    LAS unsigned* vnT32 = (LAS unsigned*)lds;
    LAS float* stats = (LAS float*)(lds + 139264);
    const float* lng = p->in[4] + l * 1024; const float* lnb = p->in[5] + l * 1024;
#pragma unroll 1
    for (int tb = 0; tb < 16; tb += 4) {
        u32x4 a[4], b[4];
#pragma unroll
        for (int q = 0; q < 4; ++q) { const bf16_t* row = HM + (size_t)(n * 128 + wid * 16 + tb + q) * HMW + C_V; a[q] = *(const u32x4*)(row + lane * 8); b[q] = *(const u32x4*)(row + 512 + lane * 8); }
        float mean[4], rstd[4];
#pragma unroll
        for (int q = 0; q < 4; ++q) { const float sm = ((bflo(a[q].x) + bfhi(a[q].x)) + (bflo(a[q].y) + bfhi(a[q].y))) + ((bflo(a[q].z) + bfhi(a[q].z)) + (bflo(a[q].w) + bfhi(a[q].w)))
                + ((bflo(b[q].x) + bfhi(b[q].x)) + (bflo(b[q].y) + bfhi(b[q].y))) + ((bflo(b[q].z) + bfhi(b[q].z)) + (bflo(b[q].w) + bfhi(b[q].w)));
            mean[q] = sm; }
#pragma unroll
        for (int o = 1; o < 64; o <<= 1) {
#pragma unroll
            for (int q = 0; q < 4; ++q) mean[q] += __shfl_xor(mean[q], o); }
#pragma unroll
        for (int q = 0; q < 4; ++q) { mean[q] *= (1.f / 1024.f); const float m = mean[q];
            const float d0 = bflo(a[q].x) - m, d1 = bfhi(a[q].x) - m, d2 = bflo(a[q].y) - m, d3 = bfhi(a[q].y) - m, d4 = bflo(a[q].z) - m, d5 = bfhi(a[q].z) - m, d6 = bflo(a[q].w) - m, d7 = bfhi(a[q].w) - m;
            const float e0 = bflo(b[q].x) - m, e1 = bfhi(b[q].x) - m, e2 = bflo(b[q].y) - m, e3 = bfhi(b[q].y) - m, e4 = bflo(b[q].z) - m, e5 = bfhi(b[q].z) - m, e6 = bflo(b[q].w) - m, e7 = bfhi(b[q].w) - m;
            rstd[q] = ((d0 * d0 + d1 * d1) + (d2 * d2 + d3 * d3)) + ((d4 * d4 + d5 * d5) + (d6 * d6 + d7 * d7)) + ((e0 * e0 + e1 * e1) + (e2 * e2 + e3 * e3)) + ((e4 * e4 + e5 * e5) + (e6 * e6 + e7 * e7)); }
#pragma unroll
        for (int o = 1; o < 64; o <<= 1) {
#pragma unroll
            for (int q = 0; q < 4; ++q) rstd[q] += __shfl_xor(rstd[q], o); }
        if (lane == 0) {
#pragma unroll
            for (int q = 0; q < 4; ++q) { stats[(wid * 16 + tb + q) * 2] = mean[q]; stats[(wid * 16 + tb + q) * 2 + 1] = rsqrtf(rstd[q] * (1.f / 1024.f) + LN_EPS); } }
    }
    __syncthreads();
    {
        {
            const float m0 = stats[4 * lane], r0 = stats[4 * lane + 1], m1 = stats[4 * lane + 2], r1 = stats[4 * lane + 3];
#pragma unroll 1
            for (int ib = 0; ib < 8; ib += 2) {
                u32x4 ra[2], rb[2];
#pragma unroll
                for (int it = 0; it < 2; ++it) { const int dg = wid + 8 * (ib + it); const bf16_t* row = HM + (size_t)(n * 128 + 2 * lane) * HMW + C_V + r * 512 + dg * 8;
                    ra[it] = *(const u32x4*)row; rb[it] = *(const u32x4*)(row + HMW); }
#pragma unroll
                for (int it = 0; it < 2; ++it) { const int dg = wid + 8 * (ib + it), d0 = dg * 8, col = r * 512 + d0;
                    const f32x4 g0 = *(const f32x4*)(lng + col), g1 = *(const f32x4*)(lng + col + 4), b0 = *(const f32x4*)(lnb + col), b1 = *(const f32x4*)(lnb + col + 4);
                    const u32x4 a = ra[it], b = rb[it];
                    const float av[8] = {bflo(a.x), bfhi(a.x), bflo(a.y), bfhi(a.y), bflo(a.z), bfhi(a.z), bflo(a.w), bfhi(a.w)};
                    const float bv[8] = {bflo(b.x), bfhi(b.x), bflo(b.y), bfhi(b.y), bflo(b.z), bfhi(b.z), bflo(b.w), bfhi(b.w)};
                    const float gv[8] = {g0[0], g0[1], g0[2], g0[3], g1[0], g1[1], g1[2], g1[3]};
                    const float cv[8] = {b0[0], b0[1], b0[2], b0[3], b1[0], b1[1], b1[2], b1[3]};
                    LAS unsigned* o = vnT32 + ((d0 >> 7) * 128 + (d0 & 127)) * 68 + lane;
#pragma unroll
                    for (int i = 0; i < 8; ++i) o[i * 68] = pk2((av[i] - m0) * r0 * gv[i] + cv[i], (bv[i] - m1) * r1 * gv[i] + cv[i]); }
            }
        }
        __syncthreads();
        const int hl = wid >> 1, th = wid & 1, h = 4 * r + hl;
        const float* wbase = p->in[6] + (size_t)(l * 8 + h) * 128 * 128;
#pragma unroll 1
        for (int tti = 0; tti < 4; ++tti) {
            const int t0 = (th * 4 + tti) * 16, t = t0 + fr;
            const int nks = (t0 >> 5) + 1;
            const size_t tok = (size_t)n * 128 + t;
            f32x4 w0[4], w1[4];
#pragma unroll
            for (int ks = 0; ks < 4; ++ks) { w0[ks] = (f32x4){0.f, 0.f, 0.f, 0.f}; w1[ks] = w0[ks];
                if (ks < nks) { const float* wp = wbase + t * 128 + ks * 32 + fq * 8; w0[ks] = *(const f32x4*)wp; w1[ks] = *(const f32x4*)(wp + 4); } }
            u32x2 uu[8];
#pragma unroll
            for (int dt = 0; dt < 8; ++dt) { const int col = h * 128 + dt * 16 + fq * 4; uu[dt] = *(const u32x2*)(HM + tok * HMW + C_UG + col); }
            const float bs = p->in[7][(l * 8 + h) * 128 + t];
            f32x4 acc[8];
#pragma unroll
            for (int dt = 0; dt < 8; ++dt) acc[dt] = (f32x4){0.f, 0.f, 0.f, 0.f};
#pragma unroll
            for (int ks = 0; ks < 4; ++ks) if (ks < nks) { const int s0 = ks * 32 + fq * 8;
                u32x4 bw;
                bw.x = pk2(s0 + 0 <= t ? w0[ks][0] : 0.f, s0 + 1 <= t ? w0[ks][1] : 0.f); bw.y = pk2(s0 + 2 <= t ? w0[ks][2] : 0.f, s0 + 3 <= t ? w0[ks][3] : 0.f);
                bw.z = pk2(s0 + 4 <= t ? w1[ks][0] : 0.f, s0 + 5 <= t ? w1[ks][1] : 0.f); bw.w = pk2(s0 + 6 <= t ? w1[ks][2] : 0.f, s0 + 7 <= t ? w1[ks][3] : 0.f);
                const bf16x8 bf = __builtin_bit_cast(bf16x8, bw);
#pragma unroll
                for (int dt = 0; dt < 8; ++dt) { const bf16x8 af = *(const LAS bf16x8*)(vnT + (hl * 128 + dt * 16 + fr) * 136 + s0);
                    acc[dt] = mfma16(af, bf, acc[dt]); } }
#pragma unroll
            for (int dt = 0; dt < 8; ++dt) { const int col = h * 128 + dt * 16 + fq * 4;
                u32x2 w; w.x = pk2((acc[dt][0] + bs) * bflo(uu[dt].x), (acc[dt][1] + bs) * bfhi(uu[dt].x));
                w.y = pk2((acc[dt][2] + bs) * bflo(uu[dt].y), (acc[dt][3] + bs) * bfhi(uu[dt].y));
                *(u32x2*)(YB + tok * 1024 + col) = w; }
        }
        __syncthreads();
    }
}

__device__ __forceinline__ f32x2 glu_at(const bf16_t* hm, int tok) {
    f32x2 g = (f32x2){0.f, 0.f};
    if (tok >= 0) { const unsigned va = *(const unsigned*)(hm + (size_t)tok * HMW + C_GLU); g = (f32x2){bflo(va), bfhi(va)}; }
    return g;
}
__device__ __forceinline__ void conv_item(KP p, LAS unsigned char* lds, int l, int tile) {
    int tid_ = threadIdx.x; OPAQUE_V(tid_);
    const int tid = tid_, wid = __builtin_amdgcn_readfirstlane(tid >> 6), lane = tid & 63;
    const bf16_t* HM = (const bf16_t*)(p->ws + WS_HM);
    bf16_t* YD = (bf16_t*)(p->ws + WS_Y) + (size_t)3 * SEQ * 1024;
    LAS float* ybuf = (LAS float*)lds;
    const int t0 = tile * 32, c0 = 2 * tid;
    const bf16_t* hm = HM + c0;
    f32x2 w[31];
#pragma unroll
    for (int j = 0; j < 31; ++j) w[j] = *(const f32x2*)(p->in[10] + (size_t)(l * 31 + j) * 1024 + c0);
    const f32x2 cb = *(const f32x2*)(p->in[11] + l * 1024 + c0);
    f32x2 g[34];
#pragma unroll
    for (int i = 0; i < 30; ++i) g[i] = glu_at(hm, t0 - 30 + i);
    unsigned nv[4][4];
#pragma unroll
    for (int k = 0; k < 4; ++k)
#pragma unroll
        for (int q = 0; q < 4; ++q) nv[k][q] = *(const unsigned*)(hm + (size_t)(t0 + 4 * k + q) * HMW + C_GLU);
    u32x2 gtp[4][4];
#pragma unroll
    for (int q = 0; q < 4; ++q)
#pragma unroll
        for (int j = 0; j < 4; ++j) gtp[q][j] = *(const u32x2*)(HM + ((size_t)t0 + wid * 4 + q) * HMW + C_DGATE + lane * 4 + 256 * j);
#pragma unroll 1
    for (int blk = 0; blk < 8; ++blk) {
#pragma unroll
        for (int q = 0; q < 4; ++q) g[30 + q] = (f32x2){bflo(nv[0][q]), bfhi(nv[0][q])};
#pragma unroll
        for (int k = 0; k < 3; ++k)
#pragma unroll
            for (int q = 0; q < 4; ++q) nv[k][q] = nv[k + 1][q];
        { const int tn = t0 + (blk < 4 ? blk + 4 : 7) * 4;
#pragma unroll
          for (int q = 0; q < 4; ++q) nv[3][q] = *(const unsigned*)(hm + (size_t)(tn + q) * HMW + C_GLU); }
        f32x2 y[4] = {cb, cb, cb, cb};
#pragma unroll
        for (int j = 0; j < 31; ++j)
#pragma unroll
            for (int q = 0; q < 4; ++q) y[q] += w[j] * g[q + j];
#pragma unroll
        for (int q = 0; q < 4; ++q) *(LAS f32x2*)(ybuf + (blk * 4 + q) * 1024 + c0) = y[q];
#pragma unroll
        for (int i = 0; i < 30; ++i) g[i] = g[i + 4];
    }
    __syncthreads();
    const float* lng = p->in[12] + l * 1024; const float* lnb = p->in[13] + l * 1024;
    {
        f32x4 v[4][4]; u32x2 gt[4][4]; float mean[4], rstd[4];
#pragma unroll
        for (int q = 0; q < 4; ++q) { const int o = wid * 4 + q; float sm = 0.f;
#pragma unroll
            for (int j = 0; j < 4; ++j) { v[q][j] = *(const LAS f32x4*)(ybuf + o * 1024 + lane * 4 + 256 * j); sm += (v[q][j][0] + v[q][j][1]) + (v[q][j][2] + v[q][j][3]);
                gt[q][j] = gtp[q][j]; }
            mean[q] = sm; }
#pragma unroll
        for (int o2 = 1; o2 < 64; o2 <<= 1) {
#pragma unroll
            for (int q = 0; q < 4; ++q) mean[q] += __shfl_xor(mean[q], o2); }
#pragma unroll
        for (int q = 0; q < 4; ++q) { mean[q] *= (1.f / 1024.f); float sq = 0.f;
#pragma unroll
            for (int j = 0; j < 4; ++j) { v[q][j] = v[q][j] - mean[q]; sq += (v[q][j][0] * v[q][j][0] + v[q][j][1] * v[q][j][1]) + (v[q][j][2] * v[q][j][2] + v[q][j][3] * v[q][j][3]); }
            rstd[q] = sq; }
#pragma unroll
        for (int o2 = 1; o2 < 64; o2 <<= 1) {
#pragma unroll
            for (int q = 0; q < 4; ++q) rstd[q] += __shfl_xor(rstd[q], o2); }
#pragma unroll
        for (int q = 0; q < 4; ++q) rstd[q] = rsqrtf(rstd[q] * (1.f / 1024.f) + LN_EPS);
#pragma unroll
        for (int j = 0; j < 4; ++j) { const int c = lane * 4 + 256 * j;
            const f32x4 gg = *(const f32x4*)(lng + c), bb = *(const f32x4*)(lnb + c);
#pragma unroll
            for (int q = 0; q < 4; ++q) { const size_t tok = (size_t)t0 + wid * 4 + q;
                const f32x4 y = v[q][j] * rstd[q] * gg + bb; const u32x2 g2 = gt[q][j];
                u32x2 wv; wv.x = pk2(siluf_(y[0]) * bflo(g2.x), siluf_(y[1]) * bfhi(g2.x)); wv.y = pk2(siluf_(y[2]) * bflo(g2.y), siluf_(y[3]) * bfhi(g2.y));
                *(u32x2*)(YD + tok * 1024 + c) = wv; } }
    }
    __syncthreads();
}

__device__ __forceinline__ void pool_item(KP p, int n) {
    int tid_ = threadIdx.x; OPAQUE_V(tid_); const int tid = tid_;
    const bf16_t* HM = (const bf16_t*)(p->ws + WS_HM);
    bf16_t* MIX = (bf16_t*)(p->ws + WS_MIX);
    const int c = (tid & 127) * 8, tq = tid >> 7, g = c >> 8, w = 2 << g;
    const int ts = n * 128 + tq * 32;
    float s[8];
#pragma unroll
    for (int i = 0; i < 8; ++i) s[i] = 0.f;
    for (int tau = 1; tau <= w; ++tau) { const int tok = ts - tau; if (tok >= 0) { const u32x4 a = *(const u32x4*)(HM + (size_t)tok * HMW + C_AIN + c);
            s[0] += bflo(a.x); s[1] += bfhi(a.x); s[2] += bflo(a.y); s[3] += bfhi(a.y); s[4] += bflo(a.z); s[5] += bfhi(a.z); s[6] += bflo(a.w); s[7] += bfhi(a.w); } }
#pragma unroll 1
    for (int tb = ts; tb < ts + 32; tb += 8) {
        u32x4 av[8], bv[8];
#pragma unroll
        for (int q = 0; q < 8; ++q) { const int t = tb + q; av[q] = *(const u32x4*)(HM + (size_t)t * HMW + C_AIN + c);
            bv[q] = (u32x4){0u, 0u, 0u, 0u}; if (t - w >= 0) bv[q] = *(const u32x4*)(HM + (size_t)(t - w) * HMW + C_AIN + c); }
#pragma unroll
        for (int q = 0; q < 8; ++q) { const int t = tb + q; const u32x4 a = av[q], b = bv[q];
            const float cur[8] = {bflo(a.x), bfhi(a.x), bflo(a.y), bfhi(a.y), bflo(a.z), bfhi(a.z), bflo(a.w), bfhi(a.w)};
            const float old[8] = {bflo(b.x), bfhi(b.x), bflo(b.y), bfhi(b.y), bflo(b.z), bfhi(b.z), bflo(b.w), bfhi(b.w)};
            const float rc = 1.0f / (float)(t + 1 < w ? t + 1 : w);
            float m[8];
#pragma unroll
            for (int i = 0; i < 8; ++i) { s[i] = s[i] + cur[i] - old[i]; m[i] = s[i] * rc - cur[i]; }
            u32x4 o; o.x = pk2(m[0], m[1]); o.y = pk2(m[2], m[3]); o.z = pk2(m[4], m[5]); o.w = pk2(m[6], m[7]);
            *(u32x4*)(MIX + ((size_t)g * SEQ + t) * 256 + (c & 255)) = o; }
    }
}

#ifndef GEMM_ALIGN
#define GEMM_ALIGN true
#endif
#ifndef GEMM_SP2
#define GEMM_SP2 true
#endif
constexpr int GEMM1_EXTRA = 64;
__device__ __forceinline__ void phase_mixers(KP p, LAS unsigned char* lds, int l) {
    for (int it = blockIdx.x; it < 1280; it += gridDim.x) {
        if (it < 256) sgu_item(p, lds, l, it >> 1, it & 1);
        else if (it < 512) attn_item(p, lds, l, (it - 256) >> 1, (it - 256) & 1);
        else if (it < 768) conv_item(p, lds, l, it - 512);
        else if (it < 832) {
            unsigned char* ws = p->ws;
            pg8::Gemm g{(const bf16_t*)(ws + WS_XB), (const bf16_t*)(ws + WS_WIN + l * SZ_WIN), SEQ, DIN, DM};
            pg8::ExtraOrder S{it - 768, DIN / 256 - 1};
            pg8::EpiH E{(bf16_t*)(ws + WS_HM), (bf16_t*)(ws + WS_HG)};
            pg8::gemm_phase<GEMM_ALIGN, GEMM_SP2>(lds, g, S, E);
        }
        else if (it < 960) pool_item(p, it - 832);
        else if (it < 1024) conv_item(p, lds, l, 256 + (it - 960));
        else if (it >= 1088) conv_item(p, lds, l, 320 + (it - 1088));
    }
}

__device__ __forceinline__ void phase_ln(KP p, int l) {
    int tid_ = threadIdx.x; OPAQUE_V(tid_); const int tid = tid_, wid = tid >> 6, lane = tid & 63;
    const float* lng = p->in[16] + l * DM; const float* lnb = p->in[17] + l * DM;
    bf16_t* xb = (bf16_t*)(p->ws + WS_XB);
    for (int row = blockIdx.x * 8 + wid; row < SEQ; row += gridDim.x * 8) {
        float* xr = p->out + (size_t)row * DM + lane * 4;
        f32x4 v[8]; float sm = 0.f;
#pragma unroll
        for (int j = 0; j < 8; ++j) { v[j] = *(const f32x4*)(xr + 256 * j); sm += (v[j][0] + v[j][1]) + (v[j][2] + v[j][3]); }
        const float mean = wave_sum(sm) * (1.f / DM); float sq = 0.f;
#pragma unroll
        for (int j = 0; j < 8; ++j) { v[j] = v[j] - mean; sq += (v[j][0] * v[j][0] + v[j][1] * v[j][1]) + (v[j][2] * v[j][2] + v[j][3] * v[j][3]); }
        const float rstd = rsqrtf(wave_sum(sq) * (1.f / DM) + LN_EPS);
#pragma unroll
        for (int j = 0; j < 8; ++j) { const int c = lane * 4 + 256 * j;
            const f32x4 y = v[j] * rstd * *(const f32x4*)(lng + c) + *(const f32x4*)(lnb + c);
            *(f32x4*)(xr + 256 * j) = y;
            if (l + 1 < DEPTH) { u32x2 wv; wv.x = pk2(y[0], y[1]); wv.y = pk2(y[2], y[3]); *(u32x2*)(xb + (size_t)row * DM + c) = wv; } }
    }
}


#define XB_TMO      128
#define XB_XCNT(j)  (256  + 64 * (j))
#define XB_XSUB(j)  (1280 + 64 * (j))
#define XB_XGEN(j)  (2304 + 64 * (j))
#define XB_TOP      3328
#define XB_TOPGEN   3392
#define XCD_BAR_WORDS 3456
#define XB_SPIN_CAP (1u << 18)
__device__ __forceinline__ unsigned xb_ld(unsigned* p)              { return __hip_atomic_load(p, __ATOMIC_RELAXED, __HIP_MEMORY_SCOPE_AGENT); }
__device__ __forceinline__ unsigned xb_add(unsigned* p, unsigned v) { return __hip_atomic_fetch_add(p, v, __ATOMIC_RELAXED, __HIP_MEMORY_SCOPE_AGENT); }
__device__ __forceinline__ unsigned xb_xcc_id() { return (unsigned)__builtin_amdgcn_s_getreg((3 << 11) | 20) & 0xFu; }
#define XB_SPIN(cond, bar) do { unsigned _sp = 0; while (cond) { __builtin_amdgcn_s_sleep(1); \
    if ((++_sp & 255u) == 0u) { if (xb_ld(&(bar)[XB_TMO])) break; if (_sp > XB_SPIN_CAP) { atomicAdd(&(bar)[XB_TMO], 1u); break; } } } } while (0)
struct XcdBarrier { unsigned* bar; unsigned x; volatile LAS unsigned* st; };
__device__ __forceinline__ XcdBarrier xcd_barrier_post(unsigned* bar, volatile LAS unsigned* st) {
    XcdBarrier b; b.bar = bar; b.x = xb_xcc_id(); b.st = st;
    if (threadIdx.x == 0) (void)xb_add(&bar[XB_XCNT(b.x)], 1u);
    return b;
}
__device__ __forceinline__ void xcd_barrier_complete(unsigned* bar, unsigned x, unsigned& nloc, unsigned& nx) {
    const unsigned G = gridDim.x * gridDim.y * gridDim.z;
    unsigned sum, cnt, mine, sp = 0u;
    for (;;) {
        sum = 0u; cnt = 0u; mine = 0u;
#pragma unroll
        for (unsigned j = 0; j < 16; ++j) { const unsigned c = xb_ld(&bar[XB_XCNT(j)]); sum += c; cnt += (c > 0u) ? 1u : 0u; mine = (j == x) ? c : mine; }
        if (sum == G) break;
        __builtin_amdgcn_s_sleep(1);
        if ((++sp & 255u) == 0u) { if (xb_ld(&bar[XB_TMO])) break; if (sp > XB_SPIN_CAP) { atomicAdd(&bar[XB_TMO], 1u); break; } }
    }
    nloc = mine > 0u ? mine : 1u; nx = cnt > 0u ? cnt : 1u;
}
__device__ __forceinline__ void xcd_barrier(const XcdBarrier& b) {
    asm volatile("s_waitcnt vmcnt(0)" ::: "memory");
    __syncthreads();
    if (threadIdx.x == 0) {
        unsigned* bar = b.bar;
        __builtin_amdgcn_s_waitcnt(0);
        unsigned nloc = b.st[0], nx = b.st[1];
        if (nloc == 0u) { xcd_barrier_complete(bar, b.x, nloc, nx); b.st[0] = nloc; b.st[1] = nx; }
        const unsigned old = xb_add(&bar[XB_XSUB(b.x)], 1u);
        const unsigned gen = old / nloc;
        if (old + 1u == (gen + 1u) * nloc) {
            __builtin_amdgcn_fence(__ATOMIC_RELEASE, "agent");
            asm volatile("s_waitcnt vmcnt(0)" ::: "memory");
            const unsigned og = xb_add(&bar[XB_TOP], 1u);
            const unsigned tg = og / nx;
            if (og + 1u == (tg + 1u) * nx) xb_add(&bar[XB_TOPGEN], 1u);
            else XB_SPIN(xb_ld(&bar[XB_TOPGEN]) == tg, bar);
            __builtin_amdgcn_fence(__ATOMIC_ACQUIRE, "agent");
            xb_add(&bar[XB_XGEN(b.x)], 1u);
            asm volatile("s_waitcnt vmcnt(0)" ::: "memory");
        } else {
            XB_SPIN(xb_ld(&bar[XB_XGEN(b.x)]) == gen, bar);
            __builtin_amdgcn_fence(__ATOMIC_ACQUIRE, "agent");
            asm volatile("s_waitcnt vmcnt(0)" ::: "memory");
        }
    }
    __syncthreads();
}

#ifndef GEMM_ALIGN
#define GEMM_ALIGN true
#endif
#ifndef GEMM_SP2
#define GEMM_SP2 true
#endif
constexpr int N_PHASES = 1 + 6 * DEPTH;
__global__ void __launch_bounds__(512, 2) fwd_megakernel(Params p_unused) {
    extern __shared__ __attribute__((aligned(16))) unsigned char lds_raw[];
    LAS unsigned char* lds = (LAS unsigned char*)lds_raw;
    cg::grid_group grid = cg::this_grid();
    const int lo = kargs()->ph_lo, hi = kargs()->ph_hi;
    volatile LAS unsigned* bst = (volatile LAS unsigned*)(lds + LDS_BYTES - 64);
    if (threadIdx.x < 4) bst[threadIdx.x] = 0u;
    __syncthreads();
    XcdBarrier bar; bar.bar = (unsigned*)(kargs()->ws + WS_CTL); bar.x = xb_xcc_id(); bar.st = bst;
    if (threadIdx.x == 0) bst[3] = xb_add(&bar.bar[XB_XCNT(bar.x)], 1u);
#define IN(k) (lo <= (k) && (k) < hi)
#ifndef REP_MASK
#define REP_MASK 0u
#endif
#define REPS(i) for (int rep_ = 0; rep_ < (((REP_MASK >> (i)) & 1u) ? 2 : 1); ++rep_)
#define SEAM(k) do { if (IN(k) && IN((k) + 1)) xcd_barrier(bar); } while (0)
    if (lo < 0) grid.sync();
    if (IN(0)) REPS(0) { phase_p0(kargs(), lds); }
    SEAM(0);
    if (IN(0) && IN(1)) {
        if (threadIdx.x == 0) {
            bool even = (bst[1] == 8u) && (gridDim.x % 8u == 0u);
            for (unsigned j = 0; j < 16; ++j) { const unsigned c = xb_ld(&bar.bar[XB_XCNT(j)]); if (c != 0u && c != gridDim.x / 8u) even = false; }
            bst[2] = even ? bst[3] * 8u + bar.x : blockIdx.x; }
        __syncthreads();
    } else if (threadIdx.x == 0) bst[2] = blockIdx.x;
    __syncthreads();
    const int vc = (int)bst[2];
    for (int l = 0; l < DEPTH; ++l) {
        const int pb = 1 + 6 * l; KP p = kargs(); unsigned char* ws = p->ws;
        if (IN(pb + 0)) REPS(1) {
            pg8::Gemm g{(const bf16_t*)(ws + WS_XB), (const bf16_t*)(ws + WS_WIN + l * SZ_WIN), SEQ, DIN, DM};
            pg8::StaticOrder S; S.init(SEQ, DIN - 256, gridDim.x, vc);
            pg8::EpiH E{(bf16_t*)(ws + WS_HM), (bf16_t*)(ws + WS_HG)};
            pg8::gemm_phase<GEMM_ALIGN, GEMM_SP2>(lds, g, S, E);
        }
        SEAM(pb + 0);
        if (IN(pb + 1)) REPS(2) phase_mixers(p, lds, l);
        SEAM(pb + 1);
        if (IN(pb + 2)) REPS(3) {
            pg8::Gemm g{(const bf16_t*)(ws + WS_MIX), (const bf16_t*)(ws + WS_WP) + (size_t)l * 4 * 256 * 256, 4 * SEQ, 256, 256};
            pg8::PoolOrder S{(int)gridDim.x, (int)blockIdx.x};
            pg8::EpiPool E{(const bf16_t*)(ws + WS_HM), (bf16_t*)(ws + WS_Y)};
            pg8::gemm_phase<GEMM_ALIGN, GEMM_SP2>(lds, g, S, E);
        }
        SEAM(pb + 2);
        if (IN(pb + 3)) REPS(4) {
            pg8::Gemm g{(const bf16_t*)(ws + WS_Y), (const bf16_t*)(ws + WS_WB) + (size_t)l * 4 * 2048 * 1024, 4 * SEQ, 4 * 2048, 1024};
            pg8::BrOrder S; S.so.init(SEQ, DM, gridDim.x, vc);
            pg8::EpiBr E{(const bf16_t*)(ws + WS_HG), (bf16_t*)(ws + WS_MG)};
            pg8::gemm_phase<GEMM_ALIGN, GEMM_SP2>(lds, g, S, E);
        }
        SEAM(pb + 3);
        if (IN(pb + 4)) for (int rep_ = 0; rep_ < ((((REP_MASK >> 5) & 1u) && l == 0) ? 2 : 1); ++rep_) {
            pg8::Gemm g{(const bf16_t*)(ws + WS_MG), (const bf16_t*)(ws + WS_WO) + (size_t)l * 2048 * 2048, SEQ, DM, DM};
            pg8::StaticOrder S; S.init(SEQ, DM, gridDim.x, vc);
            pg8::EpiOut E{l == 0 ? p->in[0] : (const float*)p->out, p->out};
            pg8::gemm_phase<GEMM_ALIGN, GEMM_SP2>(lds, g, S, E);
        }
        SEAM(pb + 4);
        if (IN(pb + 5)) phase_ln(p, l);
        if (l + 1 < DEPTH) SEAM(pb + 5);
    }
#undef IN
#undef SEAM
}

extern "C" void kernel_launch(void* const* d_in, const int* in_sizes, int n_in, void* d_out, int out_size, void* d_ws, size_t ws_size, hipStream_t stream) {
    static int grid = 0;
    if (grid == 0) {
        if (n_in != 18 || out_size != SEQ * DM || ws_size < WS_END + CTL_BYTES) { fprintf(stderr, "kernel_launch: unexpected shapes (n_in %d out %d ws %zu need %zu)\n", n_in, out_size, ws_size, (size_t)WS_END); grid = -1; return; }
        int dev = 0, cus = 0, per_cu = 0;
        hipGetDevice(&dev);
        hipDeviceGetAttribute(&cus, hipDeviceAttributeMultiprocessorCount, dev);
        hipFuncSetAttribute((const void*)fwd_megakernel, hipFuncAttributeMaxDynamicSharedMemorySize, LDS_BYTES);
        hipOccupancyMaxActiveBlocksPerMultiprocessor(&per_cu, (const void*)fwd_megakernel, 512, LDS_BYTES);
        if (per_cu < 1) { fprintf(stderr, "kernel_launch: occupancy query says %d blocks per CU\n", per_cu); per_cu = 1; }
        grid = cus * per_cu;
        (void)hipGetLastError();
    }
    if (grid < 0) return;
    Params p{};
    for (int i = 0; i < 18; ++i) p.in[i] = (const float*)d_in[i];
    p.out = (float*)d_out; p.ws = (unsigned char*)d_ws;
#if N_LAUNCH_MODE == 1
    p.ph_lo = 0; p.ph_hi = N_PHASES;
    if (hipMemsetAsync((char*)d_ws + WS_CTL, 0, CTL_BYTES, stream) != hipSuccess) { fprintf(stderr, "kernel_launch: memset of barrier words failed\n"); return; }
    void* args[] = {&p};
    hipError_t e = hipLaunchCooperativeKernel((const void*)fwd_megakernel, dim3(grid), dim3(512), args, LDS_BYTES, stream);
    if (e != hipSuccess) fprintf(stderr, "cooperative launch failed: %s (grid %d)\n", hipGetErrorString(e), grid);
#else
    for (int ph = 0; ph < N_PHASES; ++ph) {
        p.ph_lo = ph; p.ph_hi = ph + 1;
        hipLaunchKernelGGL(fwd_megakernel, dim3(grid), dim3(512), LDS_BYTES, stream, p);
    }
#endif
}
```

```cpp
#include <hip/hip_runtime.h>
#include <hip/hip_cooperative_groups.h>
#include <cstdio>
namespace cg = cooperative_groups;

#define LAS __attribute__((address_space(3)))
typedef unsigned short bf16_t;
typedef short bf16x8 __attribute__((ext_vector_type(8)));
typedef float f32x4 __attribute__((ext_vector_type(4)));
typedef float f32x2 __attribute__((ext_vector_type(2)));
typedef unsigned u32x4 __attribute__((ext_vector_type(4)));
typedef unsigned u32x2 __attribute__((ext_vector_type(2)));

#ifndef N_LAUNCH_MODE
#define N_LAUNCH_MODE 1
#endif

constexpr int SEQ = 16384, DM = 2048, DIN = 18688, NMIX = 10496  , HMW = 8448  , HGW = 8192, DEPTH = 2;
constexpr int C_AIN = 0, C_AGATE = 1024, C_UG = 2048, C_V = 3072, C_Q = 4096, C_K = 5120, C_VV = 5248, C_CGATE = 5376, C_GLU = 6400, C_DGATE = 7424;
constexpr float LN_EPS = 1e-5f;
constexpr float ALPHA = 1.4142135623730951f;

constexpr size_t SZ_WIN = (size_t)DIN * DM * 2;
constexpr size_t WS_WIN = 0;
constexpr size_t WS_WB = WS_WIN + 2 * SZ_WIN;
constexpr size_t WS_WO = WS_WB + (size_t)2 * 4 * 2048 * 1024 * 2;
constexpr size_t WS_WP = WS_WO + (size_t)2 * 2048 * 2048 * 2;
constexpr size_t WS_XB = WS_WP + (size_t)2 * 4 * 256 * 256 * 2;
constexpr size_t WS_HM = WS_XB + (size_t)SEQ * DM * 2;
constexpr size_t WS_HG = WS_HM + (size_t)SEQ * HMW * 2;
constexpr size_t WS_Y = WS_HG + (size_t)SEQ * HGW * 2;
constexpr size_t WS_MIX = WS_Y + (size_t)4 * SEQ * 1024 * 2;
constexpr size_t WS_END = WS_MIX + (size_t)4 * SEQ * 256 * 2;
constexpr size_t WS_CTL = WS_END, CTL_BYTES = 16384;
constexpr size_t WS_MACC = WS_HM;
constexpr size_t WS_MG = WS_HM + (size_t)SEQ * DM * 4;
static_assert(WS_MG + (size_t)SEQ * DM * 2 <= WS_HG, "alias map");

constexpr int LDS_BYTES = 147456;

struct Params {
    const float* in[18];
    float* out;
    unsigned char* ws;
    int ph_lo, ph_hi;
};

typedef const __attribute__((address_space(4))) Params* KP;
__device__ __forceinline__ KP kargs() { KP q = (KP)__builtin_amdgcn_kernarg_segment_ptr(); asm volatile("" : "+s"(q)); return q; }
#define OPAQUE_V(x) asm volatile("" : "+v"(x))
#define OPAQUE_S(x) asm volatile("" : "+s"(x))

__device__ __forceinline__ float bflo(unsigned w) { return __uint_as_float(w << 16); }
__device__ __forceinline__ float bfhi(unsigned w) { return __uint_as_float(w & 0xffff0000u); }
typedef __bf16 bf16v2_t __attribute__((ext_vector_type(2)));
__device__ __forceinline__ unsigned pk2(float lo, float hi) { bf16v2_t v; v[0] = (__bf16)lo; v[1] = (__bf16)hi; return __builtin_bit_cast(unsigned, v); }
__device__ __forceinline__ float sigmoidf_(float x) { return __builtin_amdgcn_rcpf(1.0f + __expf(-x)); }
__device__ __forceinline__ float siluf_(float x) { return x * sigmoidf_(x); }
__device__ __forceinline__ float wave_sum(float v) {
#pragma unroll
    for (int o = 1; o < 64; o <<= 1) v += __shfl_xor(v, o);
    return v;
}
__device__ __forceinline__ f32x4 mfma16(bf16x8 a, bf16x8 b, f32x4 c) { return __builtin_amdgcn_mfma_f32_16x16x32_bf16(a, b, c, 0, 0, 0); }

__constant__ unsigned char T5_BUCKET[128] = {0, 1, 2, 3, 4, 5, 6, 7, 8, 9, 10, 11, 12, 13, 14, 15, 16, 16, 16, 17, 17, 18, 18, 18, 19, 19, 19, 20, 20, 20, 20, 21, 21, 21, 21, 22, 22, 22, 22, 22, 23, 23, 23, 23, 23, 23, 24, 24, 24, 24, 24, 24, 25, 25, 25, 25, 25, 25, 25, 26, 26, 26, 26, 26, 26, 26, 26, 27, 27, 27, 27, 27, 27, 27, 27, 27, 27, 28, 28, 28, 28, 28, 28, 28, 28, 28, 28, 29, 29, 29, 29, 29, 29, 29, 29, 29, 29, 29, 29, 30, 30, 30, 30, 30, 30, 30, 30, 30, 30, 30, 30, 30, 30, 31, 31, 31, 31, 31, 31, 31, 31, 31, 31, 31, 31, 31, 31, 31};

namespace pg8 {
constexpr int BM = 256, BK = 64, HALF = 128, HTB = HALF * BK * 2, STAGE_BYTES = 8 * HTB, NXCD = 8, WGM = 3;
__device__ __forceinline__ int lds_byte(int r, int c) { const int st = (r >> 4) * 2 + (c >> 5), rr = r & 15, cc = c & 31, ob = rr * 64 + cc * 2; return st * 1024 + (ob ^ (((ob >> 9) & 1) << 5)); }
__device__ __forceinline__ void stage_rc(int b, int& R, int& C) { const int st = b / 1024, sb = b % 1024, swz = sb ^ (((sb >> 9) & 1) << 5); R = (st >> 1) * 16 + swz / 64; C = (st & 1) * 32 + (swz % 64) / 2; }
__device__ __forceinline__ int perm32(int rho) { const int n = rho >> 4, i = rho & 15; return 8 * (i >> 2) + 4 * n + (i & 3); }

struct Unit { int pm, pn; };
struct Gemm { const bf16_t* A; const bf16_t* Bt; int M, N, K; };

struct StaticOrder {
    int nM, nN, nwg, G, c, limit;
    __device__ void init(int M, int N, int G_, int c_) { nM = M / BM; nN = N / BM; nwg = nM * nN; G = G_; c = c_; limit = nwg; }
    __device__ bool next(int i, Unit& u) const {
        const long L = (long)i * G + c; if (L >= limit) return false;
        int wgid = (int)L; { const int q = nwg / NXCD, r = nwg % NXCD, xcd = wgid % NXCD, off = wgid / NXCD; wgid = (xcd < r ? xcd * (q + 1) : r * (q + 1) + (xcd - r) * q) + off; }
        const int nig = WGM * nN, gid = wgid / nig, fm = gid * WGM, gsz = (nM - fm) < WGM ? (nM - fm) : WGM;
        u.pm = fm + ((wgid % nig) % gsz); u.pn = (wgid % nig) / gsz; return true;
    }
};
struct ExtraOrder {
    int pm, pn;
    __device__ bool next(int i, Unit& u) const { if (i != 0) return false; u.pm = pm; u.pn = pn; return true; }
};
struct PoolOrder {
    int G, c;
    __device__ bool next(int i, Unit& u) const { const int L = i * G + c; if (L >= 256) return false; u.pm = L; u.pn = L >> 6; return true; }
};
struct BrOrder {
    StaticOrder so;
    __device__ bool next(int i, Unit& u) const { Unit t; if (!so.next(i >> 2, t)) return false; const int b = i & 3; u.pm = b * 64 + t.pm; u.pn = b * 8 + t.pn; return true; }
};

template <bool ALIGN_EPI, bool SP2, class Epi, class Sched>
__device__ __forceinline__ void gemm_phase(LAS unsigned char* lds, const Gemm g, const Sched& S, const Epi& E) {
    int tid_ = threadIdx.x; OPAQUE_V(tid_); int K_ = g.K; OPAQUE_S(K_);
    const int tid = tid_, wid = __builtin_amdgcn_readfirstlane(tid >> 6), lane = tid & 63, wr = wid >> 2, wc = wid & 3, fr = lane & 15, fq = lane >> 4;
    const int K = K_, nt = K / BK;
    unsigned voffA[2], voffB[2];
#pragma unroll
    for (int i = 0; i < 2; ++i) { int R, C; stage_rc(tid * 16 + i * 8192, R, C); const int Rb = Epi::PERM ? ((R & ~31) + perm32(R & 31)) : R;
        voffA[i] = (unsigned)(R * K + C) * 2u; voffB[i] = (unsigned)(Rb * K + C) * 2u; }
    const size_t kstep = (size_t)(BK * 2);
    const size_t hstep = (size_t)HALF * K * 2;
    const size_t tstep = 2 * hstep;
    const unsigned ldsw = (unsigned)wid * 1024u;
    const int aoff = lds_byte(wr * 64 + fr, fq * 8), boff = lds_byte(wc * 32 + fr, fq * 8);
#define PG8_SA(b, h) (((b) * 2 + (h)) * HTB)
#define PG8_SB(b, h) ((4 + (b) * 2 + (h)) * HTB)
#define PG8_STAGE(bufoff, gbase, voff) do { _Pragma("unroll") for (int _i = 0; _i < 2; ++_i) \
        __builtin_amdgcn_global_load_lds((const unsigned*)((const char*)(gbase) + (voff)[_i]), (LAS unsigned*)(lds + (bufoff) + ldsw + _i * 8192), 16, 0, 0); } while (0)
#define PG8_LDA(dst, b, h) do { _Pragma("unroll") for (int m = 0; m < 4; ++m) _Pragma("unroll") for (int k = 0; k < 2; ++k) dst[m][k] = *(const LAS bf16x8*)(lds + PG8_SA(b, h) + aoff + m * 2048 + k * 1024); } while (0)
#define PG8_LDB(dst, b, h) do { _Pragma("unroll") for (int n = 0; n < 2; ++n) _Pragma("unroll") for (int k = 0; k < 2; ++k) dst[n][k] = *(const LAS bf16x8*)(lds + PG8_SB(b, h) + boff + n * 2048 + k * 1024); } while (0)
#define PG8_MMA(ai, bj, At, Bt) do { __builtin_amdgcn_s_setprio(1); _Pragma("unroll") for (int m = 0; m < 4; ++m) _Pragma("unroll") for (int n = 0; n < 2; ++n) _Pragma("unroll") for (int k = 0; k < 2; ++k) \
        acc[ai][bj][m][n] = __builtin_amdgcn_mfma_f32_16x16x32_bf16(Bt[n][k], At[m][k], acc[ai][bj][m][n], 0, 0, 0); __builtin_amdgcn_s_setprio(0); } while (0)
#define PG8_WAIT_V(n) asm volatile("s_waitcnt vmcnt(" #n ")" ::: "memory")
#define PG8_WAIT_L(n) asm volatile("s_waitcnt lgkmcnt(" #n ")" ::: "memory")
#define PG8_BAR __builtin_amdgcn_s_barrier()
#define PG8_SCHED __builtin_amdgcn_sched_barrier(0)
    Unit cur, nxt; int ui = 0;
    if (!S.next(0, cur)) return;
    f32x4 acc[2][2][4][2];
#pragma unroll
    for (int a = 0; a < 2; ++a)
#pragma unroll
        for (int b = 0; b < 2; ++b)
#pragma unroll
            for (int m = 0; m < 4; ++m)
#pragma unroll
                for (int n = 0; n < 2; ++n) acc[a][b][m][n] = (f32x4){0.f, 0.f, 0.f, 0.f};
    bf16x8 At[4][2], B0[2][2], B1[2][2];
    const char* cA = (const char*)g.A + (size_t)cur.pm * tstep; const char* cB = (const char*)g.Bt + (size_t)cur.pn * tstep;
    if constexpr (SP2) {
        PG8_STAGE(PG8_SB(0, 0), cB, voffB); PG8_STAGE(PG8_SB(0, 1), cB + hstep, voffB); PG8_STAGE(PG8_SA(0, 0), cA, voffA); PG8_STAGE(PG8_SA(0, 1), cA + hstep, voffA);
        if (wr == 1) PG8_BAR;
        PG8_WAIT_V(2); PG8_BAR;
        PG8_STAGE(PG8_SB(1, 0), cB + kstep, voffB); PG8_STAGE(PG8_SA(1, 0), cA + kstep, voffA); PG8_STAGE(PG8_SB(1, 1), cB + hstep + kstep, voffB);
        PG8_WAIT_V(6); PG8_BAR;
    } else {
        PG8_STAGE(PG8_SB(0, 0), cB, voffB); PG8_STAGE(PG8_SA(0, 0), cA, voffA); PG8_STAGE(PG8_SB(0, 1), cB + hstep, voffB); PG8_STAGE(PG8_SA(0, 1), cA + hstep, voffA);
        if (wr == 1) PG8_BAR;
        PG8_WAIT_V(4); PG8_BAR;
        PG8_STAGE(PG8_SB(1, 0), cB + kstep, voffB); PG8_STAGE(PG8_SA(1, 0), cA + kstep, voffA); PG8_STAGE(PG8_SB(1, 1), cB + hstep + kstep, voffB);
        PG8_WAIT_V(6); PG8_BAR;
    }
    for (;;) {
        const bool has_next = S.next(ui + 1, nxt);
        const char* nA = has_next ? (const char*)g.A + (size_t)nxt.pm * tstep : cA; const char* nB = has_next ? (const char*)g.Bt + (size_t)nxt.pn * tstep : cB;
        for (int t = 0; t < nt; t += 2) {
            const bool last = (t == nt - 2);
            const char* a1 = cA + (size_t)(t + 1) * kstep;
            const char* a2 = last ? nA : cA + (size_t)(t + 2) * kstep; const char* b2 = last ? nB : cB + (size_t)(t + 2) * kstep;
            const char* a3 = a2 + kstep; const char* b3 = b2 + kstep;
            if constexpr (SP2) {
            PG8_STAGE(PG8_SA(1, 1), a1 + hstep, voffA); PG8_SCHED; PG8_LDB(B0, 0, 0); PG8_LDB(B1, 0, 1); PG8_SCHED; PG8_LDA(At, 0, 0);
            PG8_WAIT_V(8); PG8_WAIT_L(0); PG8_BAR; PG8_MMA(0, 0, At, B0); PG8_MMA(0, 1, At, B1); PG8_BAR; PG8_SCHED;
            PG8_STAGE(PG8_SB(0, 0), b2, voffB); PG8_STAGE(PG8_SB(0, 1), b2 + hstep, voffB); PG8_STAGE(PG8_SA(0, 0), a2, voffA); PG8_SCHED; PG8_LDA(At, 0, 1);
            PG8_WAIT_V(8); PG8_WAIT_L(0); PG8_BAR; PG8_MMA(1, 0, At, B0); PG8_MMA(1, 1, At, B1); PG8_BAR; PG8_SCHED;
            PG8_STAGE(PG8_SA(0, 1), a2 + hstep, voffA); PG8_SCHED; PG8_LDB(B0, 1, 0); PG8_LDB(B1, 1, 1); PG8_SCHED; PG8_LDA(At, 1, 0);
            PG8_WAIT_V(8); PG8_WAIT_L(0); PG8_BAR; PG8_MMA(0, 0, At, B0); PG8_MMA(0, 1, At, B1); PG8_BAR; PG8_SCHED;
            PG8_STAGE(PG8_SB(1, 0), b3, voffB); PG8_STAGE(PG8_SB(1, 1), b3 + hstep, voffB); PG8_STAGE(PG8_SA(1, 0), a3, voffA); PG8_SCHED; PG8_LDA(At, 1, 1);
            PG8_WAIT_V(8); PG8_WAIT_L(0); PG8_BAR; PG8_MMA(1, 0, At, B0); PG8_MMA(1, 1, At, B1); PG8_BAR; PG8_SCHED;
            } else {
            PG8_LDB(B0, 0, 0); PG8_SCHED; PG8_LDA(At, 0, 0); PG8_STAGE(PG8_SA(1, 1), a1 + hstep, voffA);
            PG8_WAIT_L(8); PG8_BAR; PG8_WAIT_L(0); PG8_MMA(0, 0, At, B0); PG8_BAR; PG8_SCHED;
            PG8_LDB(B1, 0, 1); PG8_STAGE(PG8_SB(0, 0), b2, voffB);
            PG8_BAR; PG8_WAIT_L(0); PG8_MMA(0, 1, At, B1); PG8_BAR;
            PG8_LDA(At, 0, 1); PG8_STAGE(PG8_SA(0, 0), a2, voffA);
            PG8_BAR; PG8_WAIT_L(0); PG8_MMA(1, 0, At, B0); PG8_BAR; PG8_SCHED;
            PG8_STAGE(PG8_SB(0, 1), b2 + hstep, voffB);
            PG8_WAIT_V(6); PG8_BAR; PG8_MMA(1, 1, At, B1); PG8_BAR;
            PG8_LDB(B0, 1, 0); PG8_SCHED; PG8_LDA(At, 1, 0); PG8_STAGE(PG8_SA(0, 1), a2 + hstep, voffA);
            PG8_WAIT_L(8); PG8_BAR; PG8_WAIT_L(0); PG8_MMA(0, 0, At, B0); PG8_BAR; PG8_SCHED;
            PG8_LDB(B1, 1, 1); PG8_STAGE(PG8_SB(1, 0), b3, voffB);
            PG8_BAR; PG8_WAIT_L(0); PG8_MMA(0, 1, At, B1); PG8_BAR;
            PG8_LDA(At, 1, 1); PG8_STAGE(PG8_SA(1, 0), a3, voffA);
            PG8_BAR; PG8_WAIT_L(0); PG8_MMA(1, 0, At, B0); PG8_BAR; PG8_SCHED;
            PG8_STAGE(PG8_SB(1, 1), b3 + hstep, voffB);
            PG8_WAIT_V(6); PG8_BAR; PG8_MMA(1, 1, At, B1); PG8_BAR;
            }
        }
        if constexpr (ALIGN_EPI) { if (wr == 0) PG8_BAR; }
        E(acc, cur, wr, wc, fr, fq);
        if (!has_next) break;
        if (E.zero_after(cur))
#pragma unroll
        for (int a = 0; a < 2; ++a)
#pragma unroll
            for (int b = 0; b < 2; ++b)
#pragma unroll
                for (int m = 0; m < 4; ++m)
#pragma unroll
                    for (int n = 0; n < 2; ++n) acc[a][b][m][n] = (f32x4){0.f, 0.f, 0.f, 0.f};
        cur = nxt; cA = nA; cB = nB; ++ui;
        if constexpr (ALIGN_EPI) { if (wr == 1) PG8_BAR; }
    }
    PG8_WAIT_V(0);
    if constexpr (!ALIGN_EPI) { if (wr == 0) PG8_BAR; }
    PG8_BAR;
#undef PG8_SA
#undef PG8_SB
#undef PG8_STAGE
#undef PG8_LDA
#undef PG8_LDB
#undef PG8_MMA
#undef PG8_WAIT_V
#undef PG8_WAIT_L
#undef PG8_BAR
#undef PG8_SCHED
}

struct EpiH {
    static constexpr bool PERM = true, PROBE2X = true;
    bf16_t* HM; bf16_t* HG;
    __device__ __forceinline__ bool zero_after(const Unit&) const { return true; }
    __device__ __forceinline__ void operator()(f32x4 (&acc)[2][2][4][2], const Unit& u, int wr, int wc, int fr, int fq) const {
        const int pn = u.pn;
        int act = 0; float scale = 1.f; int colt;
        if (pn < 8) { colt = pn * 256; if (pn >= 4) act = 1; }
        else if (pn < 16) { colt = C_UG + (pn - 8) * 128; act = 3; }
        else if (pn < 20) colt = C_V + (pn - 16) * 256;
        else if (pn < 24) { colt = C_Q + (pn - 20) * 256; scale = 0.125f; }
        else if (pn < 25) colt = C_K;
        else if (pn < 29) { colt = C_CGATE + (pn - 25) * 256; act = 1; }
        else if (pn < 37) { colt = C_GLU + (pn - 29) * 128; act = 4; }
        else { colt = C_DGATE + (pn - 37) * 256; act = 1; }
        if (pn >= 41) {
            const int row0 = u.pm * BM + wr * 64 + fr, d0 = (pn - 41) * 64 + wc * 16 + 4 * fq;
#pragma unroll
            for (int ai = 0; ai < 2; ++ai)
#pragma unroll
                for (int m = 0; m < 4; ++m) { bf16_t* rowp = HG + (size_t)(row0 + ai * HALF + m * 16) * HGW + d0;
                    u32x2 w[4];
#pragma unroll
                    for (int jp = 0; jp < 2; ++jp) { float r[2][4];
#pragma unroll
                        for (int jj = 0; jj < 2; ++jj) { const int j = 2 * jp + jj; float e[4];
#pragma unroll
                            for (int i = 0; i < 4; ++i) e[i] = 1.0f + __expf(-fminf(fmaxf(acc[ai][i >> 1][m][i & 1][j], -30.f), 30.f));
                            r[jj][0] = e[1] * __builtin_amdgcn_rcpf(e[0]); r[jj][1] = e[2] * __builtin_amdgcn_rcpf(e[1]); r[jj][2] = e[3] * __builtin_amdgcn_rcpf(e[2]); r[jj][3] = __builtin_amdgcn_rcpf(e[3]); }
#pragma unroll
                        for (int k = 0; k < 4; ++k) { const unsigned pk = pk2(r[0][k], r[1][k]); if (jp == 0) w[k].x = pk; else w[k].y = pk; } }
#pragma unroll
                    for (int k = 0; k < 4; ++k) *(u32x2*)(rowp + k * 2048) = w[k];
                    asm volatile("" ::: "memory"); }
            return;
        }
        bf16_t* base = HM; const int ldc = HMW;
        if (act >= 3) {
            const int row0 = u.pm * BM + wr * 64 + fr, col0 = colt + wc * 32 + 8 * fq;
#pragma unroll
            for (int ai = 0; ai < 2; ++ai)
#pragma unroll
                for (int m = 0; m < 4; ++m) { bf16_t* rowp = base + (size_t)(row0 + ai * HALF + m * 16) * ldc + col0;
                    f32x4 v0 = acc[ai][0][m][0], v1 = acc[ai][0][m][1]; const f32x4 g0 = acc[ai][1][m][0], g1 = acc[ai][1][m][1];
#pragma unroll
                    for (int j = 0; j < 4; ++j) { const float s0 = sigmoidf_(g0[j]), s1 = sigmoidf_(g1[j]);
                        v0[j] *= (act == 3) ? g0[j] * s0 : s0; v1[j] *= (act == 3) ? g1[j] * s1 : s1; }
                    u32x4 w; w.x = pk2(v0[0], v0[1]); w.y = pk2(v0[2], v0[3]); w.z = pk2(v1[0], v1[1]); w.w = pk2(v1[2], v1[3]);
                    *(u32x4*)rowp = w; }
            return;
        }
        const int row0 = u.pm * BM + wr * 64 + fr, col0 = colt + wc * 32 + 8 * fq;
#pragma unroll
        for (int ai = 0; ai < 2; ++ai)
#pragma unroll
            for (int m = 0; m < 4; ++m) { bf16_t* rowp = base + (size_t)(row0 + ai * HALF + m * 16) * ldc + col0;
#pragma unroll
                for (int bj = 0; bj < 2; ++bj) { f32x4 v0 = acc[ai][bj][m][0] * scale, v1 = acc[ai][bj][m][1] * scale;
                    if (act == 1) {
#pragma unroll
                        for (int j = 0; j < 4; ++j) { v0[j] = siluf_(v0[j]); v1[j] = siluf_(v1[j]); } }
                    u32x4 w; w.x = pk2(v0[0], v0[1]); w.y = pk2(v0[2], v0[3]); w.z = pk2(v1[0], v1[1]); w.w = pk2(v1[2], v1[3]);
                    *(u32x4*)(rowp + bj * HALF) = w; } }
    }
};
struct EpiPool {
    static constexpr bool PERM = true, PROBE2X = false;
    const bf16_t* HM; bf16_t* YA;
    __device__ __forceinline__ bool zero_after(const Unit&) const { return true; }
    __device__ __forceinline__ void operator()(f32x4 (&acc)[2][2][4][2], const Unit& u, int wr, int wc, int fr, int fq) const {
        const int g = u.pm >> 6; const int row0 = (u.pm & 63) * BM + wr * 64 + fr, col0 = g * 256 + wc * 32 + 8 * fq;
#pragma unroll
        for (int ai = 0; ai < 2; ++ai)
#pragma unroll
            for (int m = 0; m < 4; ++m) { const size_t row = (size_t)(row0 + ai * HALF + m * 16);
#pragma unroll
                for (int bj = 0; bj < 2; ++bj) { const int col = col0 + bj * HALF;
                    const u32x4 gt = *(const u32x4*)(HM + row * HMW + C_AGATE + col);
                    const f32x4 v0 = acc[ai][bj][m][0], v1 = acc[ai][bj][m][1];
                    u32x4 w; w.x = pk2(v0[0] * bflo(gt.x), v0[1] * bfhi(gt.x)); w.y = pk2(v0[2] * bflo(gt.y), v0[3] * bfhi(gt.y));
                    w.z = pk2(v1[0] * bflo(gt.z), v1[1] * bfhi(gt.z)); w.w = pk2(v1[2] * bflo(gt.w), v1[3] * bfhi(gt.w));
                    *(u32x4*)(YA + row * 1024 + col) = w; } }
    }
};
struct EpiBr {
    static constexpr bool PERM = true, PROBE2X = false;
    const bf16_t* HG; bf16_t* MG;
    __device__ __forceinline__ bool zero_after(const Unit& u) const { return (u.pm >> 6) == 3; }
    __device__ __forceinline__ void operator()(f32x4 (&acc)[2][2][4][2], const Unit& u, int wr, int wc, int fr, int fq) const {
        const int br = u.pm >> 6; const int row0 = (u.pm & 63) * BM + wr * 64 + fr, col0 = (u.pn & 7) * BM + wc * 32 + 8 * fq;
#pragma unroll
        for (int ai = 0; ai < 2; ++ai)
#pragma unroll
            for (int m = 0; m < 4; ++m) { const size_t row = (size_t)(row0 + ai * HALF + m * 16);
#pragma unroll
                for (int bj = 0; bj < 2; ++bj) { const int col = col0 + bj * HALF;
                    const u32x4 gt = *(const u32x4*)(HG + row * HGW + br * 2048 + col);
                    f32x4 v0 = acc[ai][bj][m][0], v1 = acc[ai][bj][m][1];
                    v0[0] *= bflo(gt.x); v0[1] *= bfhi(gt.x); v0[2] *= bflo(gt.y); v0[3] *= bfhi(gt.y);
                    v1[0] *= bflo(gt.z); v1[1] *= bfhi(gt.z); v1[2] *= bflo(gt.w); v1[3] *= bfhi(gt.w);
                    if (br < 3) { acc[ai][bj][m][0] = v0; acc[ai][bj][m][1] = v1; }
                    else { u32x4 w; w.x = pk2(v0[0], v0[1]); w.y = pk2(v0[2], v0[3]); w.z = pk2(v1[0], v1[1]); w.w = pk2(v1[2], v1[3]); *(u32x4*)(MG + row * DM + col) = w; } } }
    }
};
struct EpiOut {
    static constexpr bool PERM = false, PROBE2X = false;
    const float* xres; float* out;
    __device__ __forceinline__ bool zero_after(const Unit&) const { return true; }
    __device__ __forceinline__ void operator()(f32x4 (&acc)[2][2][4][2], const Unit& u, int wr, int wc, int fr, int fq) const {
        const int row0 = u.pm * BM + wr * 64 + fr, col0 = u.pn * BM + wc * 32 + 4 * fq;
#pragma unroll
        for (int ai = 0; ai < 2; ++ai)
#pragma unroll
            for (int m = 0; m < 4; ++m) { const size_t ro = (size_t)(row0 + ai * HALF + m * 16) * DM + col0;
#pragma unroll
                for (int bj = 0; bj < 2; ++bj)
#pragma unroll
                    for (int n = 0; n < 2; ++n) { const f32x4 xr = *(const f32x4*)(xres + ro + bj * HALF + n * 16);
                        *(f32x4*)(out + ro + bj * HALF + n * 16) = xr * ALPHA + acc[ai][bj][m][n]; } }
    }
};
}

__device__ __forceinline__ void p0_transpose_item(const float* W, int K, int N, bf16_t* WT, LAS float* scr, int item, int lane, const float* nscale = nullptr, bool gate_remap = false) {
    const int nblk = N / 32, kb = item / nblk, nb = item % nblk, k0 = 64 * kb, n0 = 32 * nb;
#pragma unroll 8
    for (int i = 0; i < 32; ++i) { const int kk = 2 * i + (lane >> 5); scr[kk * 33 + (lane & 31)] = W[(size_t)(k0 + kk) * N + n0 + (lane & 31)]; }
    asm volatile("s_waitcnt lgkmcnt(0)" ::: "memory");
    const int c = lane & 7;
#pragma unroll
    for (int j = 0; j < 4; ++j) { const int n = (lane >> 3) + 8 * j; const LAS float* s = scr + (8 * c) * 33 + n;
        const float sc = nscale ? nscale[n0 + n] : 1.0f;
        u32x4 o; o.x = pk2(s[0 * 33] * sc, s[1 * 33] * sc); o.y = pk2(s[2 * 33] * sc, s[3 * 33] * sc); o.z = pk2(s[4 * 33] * sc, s[5 * 33] * sc); o.w = pk2(s[6 * 33] * sc, s[7 * 33] * sc);
        int orow = n0 + n;
        if (gate_remap) {
            const int n_ = orow;
            if (n_ >= NMIX) { const int g = n_ - NMIX, i = g >> 11, d = g & 2047, dl = d & 63;
                orow = NMIX + (d >> 6) * 256 + 128 * (i >> 1) + 32 * (dl >> 4) + 8 * ((dl >> 2) & 3) + 4 * (i & 1) + (dl & 3); }
            else if (n_ >= 2048 && n_ < 3072) { const int ch = n_ - 2048; orow = (8 + (ch >> 7)) * 256 + (ch & 127); }
            else if (n_ >= 3072 && n_ < 4096) orow = 16 * 256 + (n_ - 3072);
            else if (n_ >= 4096 && n_ < 5120) { const int ch = n_ - 4096; orow = (8 + (ch >> 7)) * 256 + 128 + (ch & 127); }
            else if (n_ >= 7424 && n_ < 8448) { const int ch = n_ - 7424; orow = (29 + (ch >> 7)) * 256 + (ch & 127); }
            else if (n_ >= 8448 && n_ < 9472) { const int ch = n_ - 8448; orow = (29 + (ch >> 7)) * 256 + 128 + (ch & 127); } }
        *(u32x4*)(WT + (size_t)orow * K + k0 + 8 * c) = o; }
    asm volatile("s_waitcnt lgkmcnt(0)" ::: "memory");
}
__device__ __forceinline__ void phase_p0(KP p, LAS unsigned char* lds) {
    int tid_ = threadIdx.x; OPAQUE_V(tid_); const int tid = tid_, wid = tid >> 6, lane = tid & 63;
    LAS float* scr = (LAS float*)(lds + wid * 16384);
    const int gw = blockIdx.x * 8 + wid, NGW = gridDim.x * 8;
    constexpr int I_IN = 32 * 584, I_BR = 16 * 64, I_OUT = 32 * 64, I_PW = 4 * 8, PER_L = I_IN + 4 * I_BR + I_OUT + 4 * I_PW;
    for (int it = gw; it < 2 * PER_L; it += NGW) {
        const int l = it / PER_L; int r = it % PER_L;
        if (r < I_IN) { p0_transpose_item(p->in[1] + (size_t)l * DM * DIN, DM, DIN, (bf16_t*)(p->ws + WS_WIN + l * SZ_WIN), scr, r, lane, nullptr, true); continue; } r -= I_IN;
        if (r < 4 * I_BR) { const int i = r / I_BR; p0_transpose_item(p->in[14] + (size_t)(l * 4 + i) * 1024 * 2048, 1024, 2048, (bf16_t*)(p->ws + WS_WB) + (size_t)(l * 4 + i) * 2048 * 1024, scr, r % I_BR, lane); continue; } r -= 4 * I_BR;
        if (r < I_OUT) { p0_transpose_item(p->in[15] + (size_t)l * 2048 * 2048, 2048, 2048, (bf16_t*)(p->ws + WS_WO) + (size_t)l * 2048 * 2048, scr, r, lane); continue; } r -= I_OUT;
        { const int g = r / I_PW; p0_transpose_item(p->in[2] + (size_t)(l * 4 + g) * 256 * 256, 256, 256, (bf16_t*)(p->ws + WS_WP) + (size_t)(l * 4 + g) * 256 * 256, scr, r % I_PW, lane, p->in[3] + l * 1024 + g * 256); }
    }
    const float* x = p->in[0]; bf16_t* xb = (bf16_t*)(p->ws + WS_XB);
    const size_t n8 = (size_t)SEQ * DM / 8;
    for (size_t i = (size_t)blockIdx.x * 512 + tid; i < n8; i += (size_t)gridDim.x * 512) {
        const f32x4 a = *(const f32x4*)(x + i * 8), b = *(const f32x4*)(x + i * 8 + 4);
        u32x4 w; w.x = pk2(a[0], a[1]); w.y = pk2(a[2], a[3]); w.z = pk2(b[0], b[1]); w.w = pk2(b[2], b[3]);
        *(u32x4*)(xb + i * 8) = w;
    }
    __syncthreads();
}

__device__ __forceinline__ void attn_item(KP p, LAS unsigned char* lds, int l, int n, int hk) {
    int tid_ = threadIdx.x; OPAQUE_V(tid_);
    const int tid = tid_, wid = __builtin_amdgcn_readfirstlane(tid >> 6), lane = tid & 63, fr = lane & 15, fq = lane >> 4;
    const bf16_t* HM = (const bf16_t*)(p->ws + WS_HM);
    bf16_t* YC = (bf16_t*)(p->ws + WS_Y) + (size_t)2 * SEQ * 1024;
    LAS bf16_t* Ks = (LAS bf16_t*)lds;
    LAS unsigned* Vt32 = (LAS unsigned*)(lds + 36864);
    LAS float* bias = (LAS float*)(lds + 36864 + 35840);
    const int tokb = (n - 1) * 128;
    for (int idx = tid; idx < 2048; idx += 512) { const int key = idx >> 3, pc = idx & 7; const int tok = tokb + key;
        u32x4 v = (u32x4){0u, 0u, 0u, 0u}; if (tok >= 0) v = *(const u32x4*)(HM + (size_t)tok * HMW + C_K + hk * 64 + pc * 8);
        *(LAS u32x4*)(Ks + key * 72 + pc * 8) = v; }
    for (int idx = tid; idx < 1024; idx += 512) { const int p2 = idx & 127, dg = idx >> 7; const int tok0 = tokb + 2 * p2;
        u32x4 a = (u32x4){0u, 0u, 0u, 0u}, b = a;
        if (tok0 >= 0) { a = *(const u32x4*)(HM + (size_t)tok0 * HMW + C_VV + hk * 64 + dg * 8); b = *(const u32x4*)(HM + (size_t)(tok0 + 1) * HMW + C_VV + hk * 64 + dg * 8); }
        LAS unsigned* o = Vt32 + (dg * 8) * 140 + p2;
        o[0 * 140] = (a.x & 0xffffu) | (b.x << 16); o[1 * 140] = (a.x >> 16) | (b.x & 0xffff0000u);
        o[2 * 140] = (a.y & 0xffffu) | (b.y << 16); o[3 * 140] = (a.y >> 16) | (b.y & 0xffff0000u);
        o[4 * 140] = (a.z & 0xffffu) | (b.z << 16); o[5 * 140] = (a.z >> 16) | (b.z & 0xffff0000u);
        o[6 * 140] = (a.w & 0xffffu) | (b.w << 16); o[7 * 140] = (a.w >> 16) | (b.w & 0xffff0000u); }
    for (int idx = tid; idx < 768; idx += 512) Vt32[(idx / 12) * 140 + 128 + (idx % 12)] = 0u;
    for (int idx = tid; idx < 1024; idx += 512) { const int w = idx >> 7, d = idx & 127; bias[idx] = p->in[9][(int)T5_BUCKET[d] * 16 + hk * 8 + w]; }
    __syncthreads();
    const int h = hk * 8 + wid;
    const float sink = p->in[8][l * 16 + h];
    const LAS float* bh = bias + wid * 128;
    bf16x8 qn0, qn1;
    { const bf16_t* qrow = HM + (size_t)(n * 128 + fr) * HMW + C_Q + h * 64 + fq * 8; qn0 = *(const bf16x8*)qrow; qn1 = *(const bf16x8*)(qrow + 32); }
#pragma unroll 1
    for (int qt = 0; qt < 8; ++qt) {
        const int tok = n * 128 + qt * 16 + fr;
        const bf16x8 q0 = qn0, q1 = qn1;
        { const int tokn = n * 128 + (qt < 7 ? qt + 1 : qt) * 16 + fr; const bf16_t* qrow = HM + (size_t)tokn * HMW + C_Q + h * 64 + fq * 8; qn0 = *(const bf16x8*)qrow; qn1 = *(const bf16x8*)(qrow + 32); }
        u32x2 cg4[4];
#pragma unroll
        for (int dt = 0; dt < 4; ++dt) cg4[dt] = *(const u32x2*)(HM + (size_t)tok * HMW + C_CGATE + h * 64 + dt * 16 + fq * 4);
        f32x4 s[10];
#pragma unroll
        for (int k9 = 0; k9 < 9; ++k9) { const LAS bf16_t* kp = Ks + ((qt + k9) * 16 + fr) * 72 + fq * 8;
            f32x4 z = (f32x4){0.f, 0.f, 0.f, 0.f};
            z = mfma16(*(const LAS bf16x8*)kp, q0, z); z = mfma16(*(const LAS bf16x8*)(kp + 32), q1, z); s[k9] = z; }
        s[9] = (f32x4){0.f, 0.f, 0.f, 0.f};
        float mx = sink;
#pragma unroll
        for (int k9 = 0; k9 < 9; ++k9)
#pragma unroll
            for (int j = 0; j < 4; ++j) { const int dist = 128 - 16 * k9 + fr - fq * 4 - j; const int key = (qt + k9) * 16 + fq * 4 + j;
                const bool valid = (dist >= 0) && (dist < 128) && (n > 0 || key >= 128);
                const float lg = valid ? s[k9][j] + bh[dist & 127] : -1e30f; s[k9][j] = lg; mx = fmaxf(mx, lg); }
        mx = fmaxf(mx, __shfl_xor(mx, 16)); mx = fmaxf(mx, __shfl_xor(mx, 32));
        float sum = 0.f;
#pragma unroll
        for (int k9 = 0; k9 < 9; ++k9)
#pragma unroll
            for (int j = 0; j < 4; ++j) { const float e = __expf(s[k9][j] - mx); s[k9][j] = e; sum += e; }
        sum += __shfl_xor(sum, 16); sum += __shfl_xor(sum, 32); sum += __expf(sink - mx);
        const float inv = 1.0f / sum;
        f32x4 o[4];
#pragma unroll
        for (int dt = 0; dt < 4; ++dt) o[dt] = (f32x4){0.f, 0.f, 0.f, 0.f};
#pragma unroll
        for (int pr = 0; pr < 5; ++pr) {
            u32x4 pw; pw.x = pk2(s[2 * pr][0], s[2 * pr][1]); pw.y = pk2(s[2 * pr][2], s[2 * pr][3]); pw.z = pk2(s[2 * pr + 1][0], s[2 * pr + 1][1]); pw.w = pk2(s[2 * pr + 1][2], s[2 * pr + 1][3]);
            const bf16x8 pf = __builtin_bit_cast(bf16x8, pw);
#pragma unroll
            for (int dt = 0; dt < 4; ++dt) { const LAS unsigned* vp = Vt32 + (dt * 16 + fr) * 140 + (qt + 2 * pr) * 8 + fq * 2;
                const u32x2 lo = *(const LAS u32x2*)vp, hi = *(const LAS u32x2*)(vp + 8);
                u32x4 aw; aw.x = lo.x; aw.y = lo.y; aw.z = hi.x; aw.w = hi.y;
                o[dt] = mfma16(__builtin_bit_cast(bf16x8, aw), pf, o[dt]); } }
#pragma unroll
        for (int dt = 0; dt < 4; ++dt) { const int col = h * 64 + dt * 16 + fq * 4;
            const u32x2 gt = cg4[dt];
            u32x2 w; w.x = pk2(o[dt][0] * inv * bflo(gt.x), o[dt][1] * inv * bfhi(gt.x)); w.y = pk2(o[dt][2] * inv * bflo(gt.y), o[dt][3] * inv * bfhi(gt.y));
            *(u32x2*)(YC + (size_t)tok * 1024 + col) = w; }
    }
    __syncthreads();
}

__device__ __forceinline__ void sgu_item(KP p, LAS unsigned char* lds, int l, int n, int r) {
    int tid_ = threadIdx.x; OPAQUE_V(tid_);
    const int tid = tid_, wid = __builtin_amdgcn_readfirstlane(tid >> 6), lane = tid & 63, fr = lane & 15, fq = lane >> 4;
    const bf16_t* HM = (const bf16_t*)(p->ws + WS_HM);
    bf16_t* YB = (bf16_t*)(p->ws + WS_Y) + (size_t)1 * SEQ * 1024;
    LAS bf16_t* vnT = (LAS bf16_t*)lds;
    LAS unsigned* vnT32 = (LAS unsigned*)lds;
    LAS float* stats = (LAS float*)(lds + 139264);
    const float* lng = p->in[4] + l * 1024; const float* lnb = p->in[5] + l * 1024;
#pragma unroll 1
    for (int tb = 0; tb < 16; tb += 4) {
        u32x4 a[4], b[4];
#pragma unroll
        for (int q = 0; q < 4; ++q) { const bf16_t* row = HM + (size_t)(n * 128 + wid * 16 + tb + q) * HMW + C_V; a[q] = *(const u32x4*)(row + lane * 8); b[q] = *(const u32x4*)(row + 512 + lane * 8); }
        float mean[4], rstd[4];
#pragma unroll
        for (int q = 0; q < 4; ++q) { const float sm = ((bflo(a[q].x) + bfhi(a[q].x)) + (bflo(a[q].y) + bfhi(a[q].y))) + ((bflo(a[q].z) + bfhi(a[q].z)) + (bflo(a[q].w) + bfhi(a[q].w)))
                + ((bflo(b[q].x) + bfhi(b[q].x)) + (bflo(b[q].y) + bfhi(b[q].y))) + ((bflo(b[q].z) + bfhi(b[q].z)) + (bflo(b[q].w) + bfhi(b[q].w)));
            mean[q] = sm; }
#pragma unroll
        for (int o = 1; o < 64; o <<= 1) {
#pragma unroll
            for (int q = 0; q < 4; ++q) mean[q] += __shfl_xor(mean[q], o); }
#pragma unroll
        for (int q = 0; q < 4; ++q) { mean[q] *= (1.f / 1024.f); const float m = mean[q];
            const float d0 = bflo(a[q].x) - m, d1 = bfhi(a[q].x) - m, d2 = bflo(a[q].y) - m, d3 = bfhi(a[q].y) - m, d4 = bflo(a[q].z) - m, d5 = bfhi(a[q].z) - m, d6 = bflo(a[q].w) - m, d7 = bfhi(a[q].w) - m;
            const float e0 = bflo(b[q].x) - m, e1 = bfhi(b[q].x) - m, e2 = bflo(b[q].y) - m, e3 = bfhi(b[q].y) - m, e4 = bflo(b[q].z) - m, e5 = bfhi(b[q].z) - m, e6 = bflo(b[q].w) - m, e7 = bfhi(b[q].w) - m;
            rstd[q] = ((d0 * d0 + d1 * d1) + (d2 * d2 + d3 * d3)) + ((d4 * d4 + d5 * d5) + (d6 * d6 + d7 * d7)) + ((e0 * e0 + e1 * e1) + (e2 * e2 + e3 * e3)) + ((e4 * e4 + e5 * e5) + (e6 * e6 + e7 * e7)); }
#pragma unroll
        for (int o = 1; o < 64; o <<= 1) {
#pragma unroll
            for (int q = 0; q < 4; ++q) rstd[q] += __shfl_xor(rstd[q], o); }
        if (lane == 0) {
#pragma unroll
            for (int q = 0; q < 4; ++q) { stats[(wid * 16 + tb + q) * 2] = mean[q]; stats[(wid * 16 + tb + q) * 2 + 1] = rsqrtf(rstd[q] * (1.f / 1024.f) + LN_EPS); } }
    }
    __syncthreads();
    {
        {
            const float m0 = stats[4 * lane], r0 = stats[4 * lane + 1], m1 = stats[4 * lane + 2], r1 = stats[4 * lane + 3];
#pragma unroll 1
            for (int ib = 0; ib < 8; ib += 2) {
                u32x4 ra[2], rb[2];
#pragma unroll
                for (int it = 0; it < 2; ++it) { const int dg = wid + 8 * (ib + it); const bf16_t* row = HM + (size_t)(n * 128 + 2 * lane) * HMW + C_V + r * 512 + dg * 8;
                    ra[it] = *(const u32x4*)row; rb[it] = *(const u32x4*)(row + HMW); }
#pragma unroll
                for (int it = 0; it < 2; ++it) { const int dg = wid + 8 * (ib + it), d0 = dg * 8, col = r * 512 + d0;
                    const f32x4 g0 = *(const f32x4*)(lng + col), g1 = *(const f32x4*)(lng + col + 4), b0 = *(const f32x4*)(lnb + col), b1 = *(const f32x4*)(lnb + col + 4);
                    const u32x4 a = ra[it], b = rb[it];
                    const float av[8] = {bflo(a.x), bfhi(a.x), bflo(a.y), bfhi(a.y), bflo(a.z), bfhi(a.z), bflo(a.w), bfhi(a.w)};
                    const float bv[8] = {bflo(b.x), bfhi(b.x), bflo(b.y), bfhi(b.y), bflo(b.z), bfhi(b.z), bflo(b.w), bfhi(b.w)};
                    const float gv[8] = {g0[0], g0[1], g0[2], g0[3], g1[0], g1[1], g1[2], g1[3]};
                    const float cv[8] = {b0[0], b0[1], b0[2], b0[3], b1[0], b1[1], b1[2], b1[3]};
                    LAS unsigned* o = vnT32 + ((d0 >> 7) * 128 + (d0 & 127)) * 68 + lane;
#pragma unroll
                    for (int i = 0; i < 8; ++i) o[i * 68] = pk2((av[i] - m0) * r0 * gv[i] + cv[i], (bv[i] - m1) * r1 * gv[i] + cv[i]); }
            }
        }
        __syncthreads();
        const int hl = wid >> 1, th = wid & 1, h = 4 * r + hl;
        const float* wbase = p->in[6] + (size_t)(l * 8 + h) * 128 * 128;
#pragma unroll 1
        for (int tti = 0; tti < 4; ++tti) {
            const int t0 = (th * 4 + tti) * 16, t = t0 + fr;
            const int nks = (t0 >> 5) + 1;
            const size_t tok = (size_t)n * 128 + t;
            f32x4 w0[4], w1[4];
#pragma unroll
            for (int ks = 0; ks < 4; ++ks) { w0[ks] = (f32x4){0.f, 0.f, 0.f, 0.f}; w1[ks] = w0[ks];
                if (ks < nks) { const float* wp = wbase + t * 128 + ks * 32 + fq * 8; w0[ks] = *(const f32x4*)wp; w1[ks] = *(const f32x4*)(wp + 4); } }
            u32x2 uu[8];
#pragma unroll
            for (int dt = 0; dt < 8; ++dt) { const int col = h * 128 + dt * 16 + fq * 4; uu[dt] = *(const u32x2*)(HM + tok * HMW + C_UG + col); }
            const float bs = p->in[7][(l * 8 + h) * 128 + t];
            f32x4 acc[8];
#pragma unroll
            for (int dt = 0; dt < 8; ++dt) acc[dt] = (f32x4){0.f, 0.f, 0.f, 0.f};
#pragma unroll
            for (int ks = 0; ks < 4; ++ks) if (ks < nks) { const int s0 = ks * 32 + fq * 8;
                u32x4 bw;
                bw.x = pk2(s0 + 0 <= t ? w0[ks][0] : 0.f, s0 + 1 <= t ? w0[ks][1] : 0.f); bw.y = pk2(s0 + 2 <= t ? w0[ks][2] : 0.f, s0 + 3 <= t ? w0[ks][3] : 0.f);
                bw.z = pk2(s0 + 4 <= t ? w1[ks][0] : 0.f, s0 + 5 <= t ? w1[ks][1] : 0.f); bw.w = pk2(s0 + 6 <= t ? w1[ks][2] : 0.f, s0 + 7 <= t ? w1[ks][3] : 0.f);
                const bf16x8 bf = __builtin_bit_cast(bf16x8, bw);
#pragma unroll
                for (int dt = 0; dt < 8; ++dt) { const bf16x8 af = *(const LAS bf16x8*)(vnT + (hl * 128 + dt * 16 + fr) * 136 + s0);
                    acc[dt] = mfma16(af, bf, acc[dt]); } }
#pragma unroll
            for (int dt = 0; dt < 8; ++dt) { const int col = h * 128 + dt * 16 + fq * 4;
                u32x2 w; w.x = pk2((acc[dt][0] + bs) * bflo(uu[dt].x), (acc[dt][1] + bs) * bfhi(uu[dt].x));
                w.y = pk2((acc[dt][2] + bs) * bflo(uu[dt].y), (acc[dt][3] + bs) * bfhi(uu[dt].y));
                *(u32x2*)(YB + tok * 1024 + col) = w; }
        }
        __syncthreads();
    }
}

__device__ __forceinline__ f32x2 glu_at(const bf16_t* hm, int tok) {
    f32x2 g = (f32x2){0.f, 0.f};
    if (tok >= 0) { const unsigned va = *(const unsigned*)(hm + (size_t)tok * HMW + C_GLU); g = (f32x2){bflo(va), bfhi(va)}; }
    return g;
}
__device__ __forceinline__ void conv_item(KP p, LAS unsigned char* lds, int l, int tile) {
    int tid_ = threadIdx.x; OPAQUE_V(tid_);
    const int tid = tid_, wid = __builtin_amdgcn_readfirstlane(tid >> 6), lane = tid & 63;
    const bf16_t* HM = (const bf16_t*)(p->ws + WS_HM);
    bf16_t* YD = (bf16_t*)(p->ws + WS_Y) + (size_t)3 * SEQ * 1024;
    LAS float* ybuf = (LAS float*)lds;
    const int t0 = tile * 32, c0 = 2 * tid;
    const bf16_t* hm = HM + c0;
    f32x2 w[31];
#pragma unroll
    for (int j = 0; j < 31; ++j) w[j] = *(const f32x2*)(p->in[10] + (size_t)(l * 31 + j) * 1024 + c0);
    const f32x2 cb = *(const f32x2*)(p->in[11] + l * 1024 + c0);
    f32x2 g[34];
#pragma unroll
    for (int i = 0; i < 30; ++i) g[i] = glu_at(hm, t0 - 30 + i);
    unsigned nv[4];
#pragma unroll
    for (int q = 0; q < 4; ++q) nv[q] = *(const unsigned*)(hm + (size_t)(t0 + q) * HMW + C_GLU);
#pragma unroll 1
    for (int blk = 0; blk < 8; ++blk) {
#pragma unroll
        for (int q = 0; q < 4; ++q) g[30 + q] = (f32x2){bflo(nv[q]), bfhi(nv[q])};
        { const int tn = t0 + (blk < 7 ? blk + 1 : blk) * 4;
#pragma unroll
          for (int q = 0; q < 4; ++q) nv[q] = *(const unsigned*)(hm + (size_t)(tn + q) * HMW + C_GLU); }
        f32x2 y[4] = {cb, cb, cb, cb};
#pragma unroll
        for (int j = 0; j < 31; ++j)
#pragma unroll
            for (int q = 0; q < 4; ++q) y[q] += w[j] * g[q + j];
#pragma unroll
        for (int q = 0; q < 4; ++q) *(LAS f32x2*)(ybuf + (blk * 4 + q) * 1024 + c0) = y[q];
#pragma unroll
        for (int i = 0; i < 30; ++i) g[i] = g[i + 4];
    }
    __syncthreads();
    const float* lng = p->in[12] + l * 1024; const float* lnb = p->in[13] + l * 1024;
    for (int tt = 0; tt < 4; ++tt) { const int o = wid * 4 + tt; const size_t tok = (size_t)t0 + o;
        f32x4 v[4]; float sm = 0.f;
#pragma unroll
        for (int j = 0; j < 4; ++j) { v[j] = *(const LAS f32x4*)(ybuf + o * 1024 + lane * 4 + 256 * j); sm += (v[j][0] + v[j][1]) + (v[j][2] + v[j][3]); }
        const float mean = wave_sum(sm) * (1.f / 1024.f); float sq = 0.f;
#pragma unroll
        for (int j = 0; j < 4; ++j) { v[j] = v[j] - mean; sq += (v[j][0] * v[j][0] + v[j][1] * v[j][1]) + (v[j][2] * v[j][2] + v[j][3] * v[j][3]); }
        const float rstd = rsqrtf(wave_sum(sq) * (1.f / 1024.f) + LN_EPS);
#pragma unroll
        for (int j = 0; j < 4; ++j) { const int c = lane * 4 + 256 * j;
            const f32x4 gg = *(const f32x4*)(lng + c), bb = *(const f32x4*)(lnb + c);
            const u32x2 gt = *(const u32x2*)(HM + tok * HMW + C_DGATE + c);
            const f32x4 y = v[j] * rstd * gg + bb;
            u32x2 wv; wv.x = pk2(siluf_(y[0]) * bflo(gt.x), siluf_(y[1]) * bfhi(gt.x)); wv.y = pk2(siluf_(y[2]) * bflo(gt.y), siluf_(y[3]) * bfhi(gt.y));
            *(u32x2*)(YD + tok * 1024 + c) = wv; } }
    __syncthreads();
}

__device__ __forceinline__ void pool_item(KP p, int n) {
    int tid_ = threadIdx.x; OPAQUE_V(tid_); const int tid = tid_;
    const bf16_t* HM = (const bf16_t*)(p->ws + WS_HM);
    bf16_t* MIX = (bf16_t*)(p->ws + WS_MIX);
    const int c = (tid & 127) * 8, tq = tid >> 7, g = c >> 8, w = 2 << g;
    const int ts = n * 128 + tq * 32;
    float s[8];
#pragma unroll
    for (int i = 0; i < 8; ++i) s[i] = 0.f;
    for (int tau = 1; tau <= w; ++tau) { const int tok = ts - tau; if (tok >= 0) { const u32x4 a = *(const u32x4*)(HM + (size_t)tok * HMW + C_AIN + c);
            s[0] += bflo(a.x); s[1] += bfhi(a.x); s[2] += bflo(a.y); s[3] += bfhi(a.y); s[4] += bflo(a.z); s[5] += bfhi(a.z); s[6] += bflo(a.w); s[7] += bfhi(a.w); } }
#pragma unroll 1
    for (int tb = ts; tb < ts + 32; tb += 8) {
        u32x4 av[8], bv[8];
#pragma unroll
        for (int q = 0; q < 8; ++q) { const int t = tb + q; av[q] = *(const u32x4*)(HM + (size_t)t * HMW + C_AIN + c);
            bv[q] = (u32x4){0u, 0u, 0u, 0u}; if (t - w >= 0) bv[q] = *(const u32x4*)(HM + (size_t)(t - w) * HMW + C_AIN + c); }
#pragma unroll
        for (int q = 0; q < 8; ++q) { const int t = tb + q; const u32x4 a = av[q], b = bv[q];
            const float cur[8] = {bflo(a.x), bfhi(a.x), bflo(a.y), bfhi(a.y), bflo(a.z), bfhi(a.z), bflo(a.w), bfhi(a.w)};
            const float old[8] = {bflo(b.x), bfhi(b.x), bflo(b.y), bfhi(b.y), bflo(b.z), bfhi(b.z), bflo(b.w), bfhi(b.w)};
            const float rc = 1.0f / (float)(t + 1 < w ? t + 1 : w);
            float m[8];
#pragma unroll
            for (int i = 0; i < 8; ++i) { s[i] = s[i] + cur[i] - old[i]; m[i] = s[i] * rc - cur[i]; }
            u32x4 o; o.x = pk2(m[0], m[1]); o.y = pk2(m[2], m[3]); o.z = pk2(m[4], m[5]); o.w = pk2(m[6], m[7]);
            *(u32x4*)(MIX + ((size_t)g * SEQ + t) * 256 + (c & 255)) = o; }
    }
}

#ifndef GEMM_ALIGN
#define GEMM_ALIGN true
#endif
#ifndef GEMM_SP2
#define GEMM_SP2 true
#endif
constexpr int GEMM1_EXTRA = 64;
__device__ __forceinline__ void phase_mixers(KP p, LAS unsigned char* lds, int l) {
    for (int it = blockIdx.x; it < 1280; it += gridDim.x) {
        if (it < 256) sgu_item(p, lds, l, it >> 1, it & 1);
        else if (it < 512) attn_item(p, lds, l, (it - 256) >> 1, (it - 256) & 1);
        else if (it < 768) conv_item(p, lds, l, it - 512);
        else if (it < 832) {
            unsigned char* ws = p->ws;
            pg8::Gemm g{(const bf16_t*)(ws + WS_XB), (const bf16_t*)(ws + WS_WIN + l * SZ_WIN), SEQ, DIN, DM};
            pg8::ExtraOrder S{it - 768, DIN / 256 - 1};
            pg8::EpiH E{(bf16_t*)(ws + WS_HM), (bf16_t*)(ws + WS_HG)};
            pg8::gemm_phase<GEMM_ALIGN, GEMM_SP2>(lds, g, S, E);
        }
        else if (it < 960) pool_item(p, it - 832);
        else if (it < 1024) conv_item(p, lds, l, 256 + (it - 960));
        else if (it >= 1088) conv_item(p, lds, l, 320 + (it - 1088));
    }
}

__device__ __forceinline__ void phase_ln(KP p, int l) {
    int tid_ = threadIdx.x; OPAQUE_V(tid_); const int tid = tid_, wid = tid >> 6, lane = tid & 63;
    const float* lng = p->in[16] + l * DM; const float* lnb = p->in[17] + l * DM;
    bf16_t* xb = (bf16_t*)(p->ws + WS_XB);
    for (int row = blockIdx.x * 8 + wid; row < SEQ; row += gridDim.x * 8) {
        float* xr = p->out + (size_t)row * DM + lane * 4;
        f32x4 v[8]; float sm = 0.f;
#pragma unroll
        for (int j = 0; j < 8; ++j) { v[j] = *(const f32x4*)(xr + 256 * j); sm += (v[j][0] + v[j][1]) + (v[j][2] + v[j][3]); }
        const float mean = wave_sum(sm) * (1.f / DM); float sq = 0.f;
#pragma unroll
        for (int j = 0; j < 8; ++j) { v[j] = v[j] - mean; sq += (v[j][0] * v[j][0] + v[j][1] * v[j][1]) + (v[j][2] * v[j][2] + v[j][3] * v[j][3]); }
        const float rstd = rsqrtf(wave_sum(sq) * (1.f / DM) + LN_EPS);
#pragma unroll
        for (int j = 0; j < 8; ++j) { const int c = lane * 4 + 256 * j;
            const f32x4 y = v[j] * rstd * *(const f32x4*)(lng + c) + *(const f32x4*)(lnb + c);
            *(f32x4*)(xr + 256 * j) = y;
            if (l + 1 < DEPTH) { u32x2 wv; wv.x = pk2(y[0], y[1]); wv.y = pk2(y[2], y[3]); *(u32x2*)(xb + (size_t)row * DM + c) = wv; } }
    }
}


#define XB_TMO      128
#define XB_XCNT(j)  (256  + 64 * (j))
#define XB_XSUB(j)  (1280 + 64 * (j))
#define XB_XGEN(j)  (2304 + 64 * (j))
#define XB_TOP      3328
#define XB_TOPGEN   3392
#define XCD_BAR_WORDS 3456
#define XB_SPIN_CAP (1u << 18)
__device__ __forceinline__ unsigned xb_ld(unsigned* p)              { return __hip_atomic_load(p, __ATOMIC_RELAXED, __HIP_MEMORY_SCOPE_AGENT); }
__device__ __forceinline__ unsigned xb_add(unsigned* p, unsigned v) { return __hip_atomic_fetch_add(p, v, __ATOMIC_RELAXED, __HIP_MEMORY_SCOPE_AGENT); }
__device__ __forceinline__ unsigned xb_xcc_id() { return (unsigned)__builtin_amdgcn_s_getreg((3 << 11) | 20) & 0xFu; }
#define XB_SPIN(cond, bar) do { unsigned _sp = 0; while (cond) { __builtin_amdgcn_s_sleep(1); \
    if ((++_sp & 255u) == 0u) { if (xb_ld(&(bar)[XB_TMO])) break; if (_sp > XB_SPIN_CAP) { atomicAdd(&(bar)[XB_TMO], 1u); break; } } } } while (0)
struct XcdBarrier { unsigned* bar; unsigned x; volatile LAS unsigned* st; };
__device__ __forceinline__ XcdBarrier xcd_barrier_post(unsigned* bar, volatile LAS unsigned* st) {
    XcdBarrier b; b.bar = bar; b.x = xb_xcc_id(); b.st = st;
    if (threadIdx.x == 0) (void)xb_add(&bar[XB_XCNT(b.x)], 1u);
    return b;
}
__device__ __forceinline__ void xcd_barrier_complete(unsigned* bar, unsigned x, unsigned& nloc, unsigned& nx) {
    const unsigned G = gridDim.x * gridDim.y * gridDim.z;
    unsigned sum, cnt, mine, sp = 0u;
    for (;;) {
        sum = 0u; cnt = 0u; mine = 0u;
#pragma unroll
        for (unsigned j = 0; j < 16; ++j) { const unsigned c = xb_ld(&bar[XB_XCNT(j)]); sum += c; cnt += (c > 0u) ? 1u : 0u; mine = (j == x) ? c : mine; }
        if (sum == G) break;
        __builtin_amdgcn_s_sleep(1);
        if ((++sp & 255u) == 0u) { if (xb_ld(&bar[XB_TMO])) break; if (sp > XB_SPIN_CAP) { atomicAdd(&bar[XB_TMO], 1u); break; } }
    }
    nloc = mine > 0u ? mine : 1u; nx = cnt > 0u ? cnt : 1u;
}
__device__ __forceinline__ void xcd_barrier(const XcdBarrier& b) {
    asm volatile("s_waitcnt vmcnt(0)" ::: "memory");
    __syncthreads();
    if (threadIdx.x == 0) {
        unsigned* bar = b.bar;
        __builtin_amdgcn_s_waitcnt(0);
        unsigned nloc = b.st[0], nx = b.st[1];
        if (nloc == 0u) { xcd_barrier_complete(bar, b.x, nloc, nx); b.st[0] = nloc; b.st[1] = nx; }
        const unsigned old = xb_add(&bar[XB_XSUB(b.x)], 1u);
        const unsigned gen = old / nloc;
        if (old + 1u == (gen + 1u) * nloc) {
            __builtin_amdgcn_fence(__ATOMIC_RELEASE, "agent");
            asm volatile("s_waitcnt vmcnt(0)" ::: "memory");
            const unsigned og = xb_add(&bar[XB_TOP], 1u);
            const unsigned tg = og / nx;
            if (og + 1u == (tg + 1u) * nx) xb_add(&bar[XB_TOPGEN], 1u);
            else XB_SPIN(xb_ld(&bar[XB_TOPGEN]) == tg, bar);
            __builtin_amdgcn_fence(__ATOMIC_ACQUIRE, "agent");
            xb_add(&bar[XB_XGEN(b.x)], 1u);
            asm volatile("s_waitcnt vmcnt(0)" ::: "memory");
        } else {
            XB_SPIN(xb_ld(&bar[XB_XGEN(b.x)]) == gen, bar);
            __builtin_amdgcn_fence(__ATOMIC_ACQUIRE, "agent");
            asm volatile("s_waitcnt vmcnt(0)" ::: "memory");
        }
    }
    __syncthreads();
}

#ifndef GEMM_ALIGN
#define GEMM_ALIGN true
#endif
#ifndef GEMM_SP2
#define GEMM_SP2 true
#endif
constexpr int N_PHASES = 1 + 6 * DEPTH;
__global__ void __launch_bounds__(512, 2) fwd_megakernel(Params p_unused) {
    extern __shared__ __attribute__((aligned(16))) unsigned char lds_raw[];
    LAS unsigned char* lds = (LAS unsigned char*)lds_raw;
    cg::grid_group grid = cg::this_grid();
    const int lo = kargs()->ph_lo, hi = kargs()->ph_hi;
    volatile LAS unsigned* bst = (volatile LAS unsigned*)(lds + LDS_BYTES - 64);
    if (threadIdx.x < 4) bst[threadIdx.x] = 0u;
    __syncthreads();
    XcdBarrier bar; bar.bar = (unsigned*)(kargs()->ws + WS_CTL); bar.x = xb_xcc_id(); bar.st = bst;
    if (threadIdx.x == 0) bst[3] = xb_add(&bar.bar[XB_XCNT(bar.x)], 1u);
#define IN(k) (lo <= (k) && (k) < hi)
#ifndef REP_MASK
#define REP_MASK 0u
#endif
#define REPS(i) for (int rep_ = 0; rep_ < (((REP_MASK >> (i)) & 1u) ? 2 : 1); ++rep_)
#define SEAM(k) do { if (IN(k) && IN((k) + 1)) xcd_barrier(bar); } while (0)
    if (lo < 0) grid.sync();
    if (IN(0)) REPS(0) { phase_p0(kargs(), lds); }
    SEAM(0);
    if (IN(0) && IN(1)) {
        if (threadIdx.x == 0) {
            bool even = (bst[1] == 8u) && (gridDim.x % 8u == 0u);
            for (unsigned j = 0; j < 16; ++j) { const unsigned c = xb_ld(&bar.bar[XB_XCNT(j)]); if (c != 0u && c != gridDim.x / 8u) even = false; }
            bst[2] = even ? bst[3] * 8u + bar.x : blockIdx.x; }
        __syncthreads();
    } else if (threadIdx.x == 0) bst[2] = blockIdx.x;
    __syncthreads();
    const int vc = (int)bst[2];
    for (int l = 0; l < DEPTH; ++l) {
        const int pb = 1 + 6 * l; KP p = kargs(); unsigned char* ws = p->ws;
        if (IN(pb + 0)) REPS(1) {
            pg8::Gemm g{(const bf16_t*)(ws + WS_XB), (const bf16_t*)(ws + WS_WIN + l * SZ_WIN), SEQ, DIN, DM};
            pg8::StaticOrder S; S.init(SEQ, DIN - 256, gridDim.x, vc);
            pg8::EpiH E{(bf16_t*)(ws + WS_HM), (bf16_t*)(ws + WS_HG)};
            pg8::gemm_phase<GEMM_ALIGN, GEMM_SP2>(lds, g, S, E);
        }
        SEAM(pb + 0);
        if (IN(pb + 1)) REPS(2) phase_mixers(p, lds, l);
        SEAM(pb + 1);
        if (IN(pb + 2)) REPS(3) {
            pg8::Gemm g{(const bf16_t*)(ws + WS_MIX), (const bf16_t*)(ws + WS_WP) + (size_t)l * 4 * 256 * 256, 4 * SEQ, 256, 256};
            pg8::PoolOrder S{(int)gridDim.x, (int)blockIdx.x};
            pg8::EpiPool E{(const bf16_t*)(ws + WS_HM), (bf16_t*)(ws + WS_Y)};
            pg8::gemm_phase<GEMM_ALIGN, GEMM_SP2>(lds, g, S, E);
        }
        SEAM(pb + 2);
        if (IN(pb + 3)) REPS(4) {
            pg8::Gemm g{(const bf16_t*)(ws + WS_Y), (const bf16_t*)(ws + WS_WB) + (size_t)l * 4 * 2048 * 1024, 4 * SEQ, 4 * 2048, 1024};
            pg8::BrOrder S; S.so.init(SEQ, DM, gridDim.x, vc);
            pg8::EpiBr E{(const bf16_t*)(ws + WS_HG), (bf16_t*)(ws + WS_MG)};
            pg8::gemm_phase<GEMM_ALIGN, GEMM_SP2>(lds, g, S, E);
        }
        SEAM(pb + 3);
        if (IN(pb + 4)) for (int rep_ = 0; rep_ < ((((REP_MASK >> 5) & 1u) && l == 0) ? 2 : 1); ++rep_) {
            pg8::Gemm g{(const bf16_t*)(ws + WS_MG), (const bf16_t*)(ws + WS_WO) + (size_t)l * 2048 * 2048, SEQ, DM, DM};
            pg8::StaticOrder S; S.init(SEQ, DM, gridDim.x, vc);
            pg8::EpiOut E{l == 0 ? p->in[0] : (const float*)p->out, p->out};
            pg8::gemm_phase<GEMM_ALIGN, GEMM_SP2>(lds, g, S, E);
        }
        SEAM(pb + 4);
        if (IN(pb + 5)) phase_ln(p, l);
        if (l + 1 < DEPTH) SEAM(pb + 5);
    }
#undef IN
#undef SEAM
}

extern "C" void kernel_launch(void* const* d_in, const int* in_sizes, int n_in, void* d_out, int out_size, void* d_ws, size_t ws_size, hipStream_t stream) {
    static int grid = 0;
    if (grid == 0) {
        if (n_in != 18 || out_size != SEQ * DM || ws_size < WS_END + CTL_BYTES) { fprintf(stderr, "kernel_launch: unexpected shapes (n_in %d out %d ws %zu need %zu)\n", n_in, out_size, ws_size, (size_t)WS_END); grid = -1; return; }
        int dev = 0, cus = 0, per_cu = 0;
        hipGetDevice(&dev);
        hipDeviceGetAttribute(&cus, hipDeviceAttributeMultiprocessorCount, dev);
        hipFuncSetAttribute((const void*)fwd_megakernel, hipFuncAttributeMaxDynamicSharedMemorySize, LDS_BYTES);
        hipOccupancyMaxActiveBlocksPerMultiprocessor(&per_cu, (const void*)fwd_megakernel, 512, LDS_BYTES);
        if (per_cu < 1) { fprintf(stderr, "kernel_launch: occupancy query says %d blocks per CU\n", per_cu); per_cu = 1; }
        grid = cus * per_cu;
        (void)hipGetLastError();
    }
    if (grid < 0) return;
    Params p{};
    for (int i = 0; i < 18; ++i) p.in[i] = (const float*)d_in[i];
    p.out = (float*)d_out; p.ws = (unsigned char*)d_ws;
#if N_LAUNCH_MODE == 1
    p.ph_lo = 0; p.ph_hi = N_PHASES;
    if (hipMemsetAsync((char*)d_ws + WS_CTL, 0, CTL_BYTES, stream) != hipSuccess) { fprintf(stderr, "kernel_launch: memset of barrier words failed\n"); return; }
    void* args[] = {&p};
    hipError_t e = hipLaunchCooperativeKernel((const void*)fwd_megakernel, dim3(grid), dim3(512), args, LDS_BYTES, stream);
    if (e != hipSuccess) fprintf(stderr, "cooperative launch failed: %s (grid %d)\n", hipGetErrorString(e), grid);
#else
    for (int ph = 0; ph < N_PHASES; ++ph) {
        p.ph_lo = ph; p.ph_hi = ph + 1;
        hipLaunchKernelGGL(fwd_megakernel, dim3(grid), dim3(512), LDS_BYTES, stream, p);
    }
#endif
}
```

```cpp
#include <hip/hip_runtime.h>
#include <hip/hip_cooperative_groups.h>
#include <cstdio>
namespace cg = cooperative_groups;

#define LAS __attribute__((address_space(3)))
typedef unsigned short bf16_t;
typedef short bf16x8 __attribute__((ext_vector_type(8)));
typedef float f32x4 __attribute__((ext_vector_type(4)));
typedef float f32x2 __attribute__((ext_vector_type(2)));
typedef unsigned u32x4 __attribute__((ext_vector_type(4)));
typedef unsigned u32x2 __attribute__((ext_vector_type(2)));

#ifndef N_LAUNCH_MODE
#define N_LAUNCH_MODE 1
#endif

constexpr int SEQ = 16384, DM = 2048, DIN = 18688, NMIX = 10496  , HMW = 8448  , HGW = 8192, DEPTH = 2;
constexpr int C_AIN = 0, C_AGATE = 1024, C_UG = 2048, C_V = 3072, C_Q = 4096, C_K = 5120, C_VV = 5248, C_CGATE = 5376, C_GLU = 6400, C_DGATE = 7424;
constexpr float LN_EPS = 1e-5f;
constexpr float ALPHA = 1.4142135623730951f;

constexpr size_t SZ_WIN = (size_t)DIN * DM * 2;
constexpr size_t WS_WIN = 0;
constexpr size_t WS_WB = WS_WIN + 2 * SZ_WIN;
constexpr size_t WS_WO = WS_WB + (size_t)2 * 4 * 2048 * 1024 * 2;
constexpr size_t WS_WP = WS_WO + (size_t)2 * 2048 * 2048 * 2;
constexpr size_t WS_XB = WS_WP + (size_t)2 * 4 * 256 * 256 * 2;
constexpr size_t WS_HM = WS_XB + (size_t)SEQ * DM * 2;
constexpr size_t WS_HG = WS_HM + (size_t)SEQ * HMW * 2;
constexpr size_t WS_Y = WS_HG + (size_t)SEQ * HGW * 2;
constexpr size_t WS_MIX = WS_Y + (size_t)4 * SEQ * 1024 * 2;
constexpr size_t WS_END = WS_MIX + (size_t)4 * SEQ * 256 * 2;
constexpr size_t WS_CTL = WS_END, CTL_BYTES = 16384;
constexpr size_t WS_MACC = WS_HM;
constexpr size_t WS_MG = WS_HM + (size_t)SEQ * DM * 4;
static_assert(WS_MG + (size_t)SEQ * DM * 2 <= WS_HG, "alias map");

constexpr int LDS_BYTES = 147456;

struct Params {
    const float* in[18];
    float* out;
    unsigned char* ws;
    int ph_lo, ph_hi;
};

typedef const __attribute__((address_space(4))) Params* KP;
__device__ __forceinline__ KP kargs() { KP q = (KP)__builtin_amdgcn_kernarg_segment_ptr(); asm volatile("" : "+s"(q)); return q; }
#define OPAQUE_V(x) asm volatile("" : "+v"(x))
#define OPAQUE_S(x) asm volatile("" : "+s"(x))

__device__ __forceinline__ float bflo(unsigned w) { return __uint_as_float(w << 16); }
__device__ __forceinline__ float bfhi(unsigned w) { return __uint_as_float(w & 0xffff0000u); }
typedef __bf16 bf16v2_t __attribute__((ext_vector_type(2)));
__device__ __forceinline__ unsigned pk2(float lo, float hi) { bf16v2_t v; v[0] = (__bf16)lo; v[1] = (__bf16)hi; return __builtin_bit_cast(unsigned, v); }
__device__ __forceinline__ float sigmoidf_(float x) { return __builtin_amdgcn_rcpf(1.0f + __expf(-x)); }
__device__ __forceinline__ float siluf_(float x) { return x * sigmoidf_(x); }
__device__ __forceinline__ float wave_sum(float v) {
#pragma unroll
    for (int o = 1; o < 64; o <<= 1) v += __shfl_xor(v, o);
    return v;
}
__device__ __forceinline__ f32x4 mfma16(bf16x8 a, bf16x8 b, f32x4 c) { return __builtin_amdgcn_mfma_f32_16x16x32_bf16(a, b, c, 0, 0, 0); }

__constant__ unsigned char T5_BUCKET[128] = {0, 1, 2, 3, 4, 5, 6, 7, 8, 9, 10, 11, 12, 13, 14, 15, 16, 16, 16, 17, 17, 18, 18, 18, 19, 19, 19, 20, 20, 20, 20, 21, 21, 21, 21, 22, 22, 22, 22, 22, 23, 23, 23, 23, 23, 23, 24, 24, 24, 24, 24, 24, 25, 25, 25, 25, 25, 25, 25, 26, 26, 26, 26, 26, 26, 26, 26, 27, 27, 27, 27, 27, 27, 27, 27, 27, 27, 28, 28, 28, 28, 28, 28, 28, 28, 28, 28, 29, 29, 29, 29, 29, 29, 29, 29, 29, 29, 29, 29, 30, 30, 30, 30, 30, 30, 30, 30, 30, 30, 30, 30, 30, 30, 31, 31, 31, 31, 31, 31, 31, 31, 31, 31, 31, 31, 31, 31, 31};

namespace pg8 {
constexpr int BM = 256, BK = 64, HALF = 128, HTB = HALF * BK * 2, STAGE_BYTES = 8 * HTB, NXCD = 8, WGM = 3;
__device__ __forceinline__ int lds_byte(int r, int c) { const int st = (r >> 4) * 2 + (c >> 5), rr = r & 15, cc = c & 31, ob = rr * 64 + cc * 2; return st * 1024 + (ob ^ (((ob >> 9) & 1) << 5)); }
__device__ __forceinline__ void stage_rc(int b, int& R, int& C) { const int st = b / 1024, sb = b % 1024, swz = sb ^ (((sb >> 9) & 1) << 5); R = (st >> 1) * 16 + swz / 64; C = (st & 1) * 32 + (swz % 64) / 2; }
__device__ __forceinline__ int perm32(int rho) { const int n = rho >> 4, i = rho & 15; return 8 * (i >> 2) + 4 * n + (i & 3); }

struct Unit { int pm, pn; };
struct Gemm { const bf16_t* A; const bf16_t* Bt; int M, N, K; };

struct StaticOrder {
    int nM, nN, nwg, G, c, limit;
    __device__ void init(int M, int N, int G_, int c_) { nM = M / BM; nN = N / BM; nwg = nM * nN; G = G_; c = c_; limit = nwg; }
    __device__ bool next(int i, Unit& u) const {
        const long L = (long)i * G + c; if (L >= limit) return false;
        int wgid = (int)L; { const int q = nwg / NXCD, r = nwg % NXCD, xcd = wgid % NXCD, off = wgid / NXCD; wgid = (xcd < r ? xcd * (q + 1) : r * (q + 1) + (xcd - r) * q) + off; }
        const int nig = WGM * nN, gid = wgid / nig, fm = gid * WGM, gsz = (nM - fm) < WGM ? (nM - fm) : WGM;
        u.pm = fm + ((wgid % nig) % gsz); u.pn = (wgid % nig) / gsz; return true;
    }
};
struct ExtraOrder {
    int pm, pn;
    __device__ bool next(int i, Unit& u) const { if (i != 0) return false; u.pm = pm; u.pn = pn; return true; }
};
struct PoolOrder {
    int G, c;
    __device__ bool next(int i, Unit& u) const { const int L = i * G + c; if (L >= 256) return false; u.pm = L; u.pn = L >> 6; return true; }
};
struct BrOrder {
    StaticOrder so;
    __device__ bool next(int i, Unit& u) const { Unit t; if (!so.next(i >> 2, t)) return false; const int b = i & 3; u.pm = b * 64 + t.pm; u.pn = b * 8 + t.pn; return true; }
};

template <bool ALIGN_EPI, bool SP2, class Epi, class Sched>
__device__ __forceinline__ void gemm_phase(LAS unsigned char* lds, const Gemm g, const Sched& S, const Epi& E) {
    int tid_ = threadIdx.x; OPAQUE_V(tid_); int K_ = g.K; OPAQUE_S(K_);
    const int tid = tid_, wid = __builtin_amdgcn_readfirstlane(tid >> 6), lane = tid & 63, wr = wid >> 2, wc = wid & 3, fr = lane & 15, fq = lane >> 4;
    const int K = K_, nt = K / BK;
    unsigned voffA[2], voffB[2];
#pragma unroll
    for (int i = 0; i < 2; ++i) { int R, C; stage_rc(tid * 16 + i * 8192, R, C); const int Rb = Epi::PERM ? ((R & ~31) + perm32(R & 31)) : R;
        voffA[i] = (unsigned)(R * K + C) * 2u; voffB[i] = (unsigned)(Rb * K + C) * 2u; }
    const size_t kstep = (size_t)(BK * 2);
    const size_t hstep = (size_t)HALF * K * 2;
    const size_t tstep = 2 * hstep;
    const unsigned ldsw = (unsigned)wid * 1024u;
    const int aoff = lds_byte(wr * 64 + fr, fq * 8), boff = lds_byte(wc * 32 + fr, fq * 8);
#define PG8_SA(b, h) (((b) * 2 + (h)) * HTB)
#define PG8_SB(b, h) ((4 + (b) * 2 + (h)) * HTB)
#define PG8_STAGE(bufoff, gbase, voff) do { _Pragma("unroll") for (int _i = 0; _i < 2; ++_i) \
        __builtin_amdgcn_global_load_lds((const unsigned*)((const char*)(gbase) + (voff)[_i]), (LAS unsigned*)(lds + (bufoff) + ldsw + _i * 8192), 16, 0, 0); } while (0)
#define PG8_LDA(dst, b, h) do { _Pragma("unroll") for (int m = 0; m < 4; ++m) _Pragma("unroll") for (int k = 0; k < 2; ++k) dst[m][k] = *(const LAS bf16x8*)(lds + PG8_SA(b, h) + aoff + m * 2048 + k * 1024); } while (0)
#define PG8_LDB(dst, b, h) do { _Pragma("unroll") for (int n = 0; n < 2; ++n) _Pragma("unroll") for (int k = 0; k < 2; ++k) dst[n][k] = *(const LAS bf16x8*)(lds + PG8_SB(b, h) + boff + n * 2048 + k * 1024); } while (0)
#define PG8_MMA(ai, bj, At, Bt) do { __builtin_amdgcn_s_setprio(1); _Pragma("unroll") for (int m = 0; m < 4; ++m) _Pragma("unroll") for (int n = 0; n < 2; ++n) _Pragma("unroll") for (int k = 0; k < 2; ++k) \
        acc[ai][bj][m][n] = __builtin_amdgcn_mfma_f32_16x16x32_bf16(Bt[n][k], At[m][k], acc[ai][bj][m][n], 0, 0, 0); __builtin_amdgcn_s_setprio(0); } while (0)
#define PG8_WAIT_V(n) asm volatile("s_waitcnt vmcnt(" #n ")" ::: "memory")
#define PG8_WAIT_L(n) asm volatile("s_waitcnt lgkmcnt(" #n ")" ::: "memory")
#define PG8_BAR __builtin_amdgcn_s_barrier()
#define PG8_SCHED __builtin_amdgcn_sched_barrier(0)
    Unit cur, nxt; int ui = 0;
    if (!S.next(0, cur)) return;
    f32x4 acc[2][2][4][2];
#pragma unroll
    for (int a = 0; a < 2; ++a)
#pragma unroll
        for (int b = 0; b < 2; ++b)
#pragma unroll
            for (int m = 0; m < 4; ++m)
#pragma unroll
                for (int n = 0; n < 2; ++n) acc[a][b][m][n] = (f32x4){0.f, 0.f, 0.f, 0.f};
    bf16x8 At[4][2], B0[2][2], B1[2][2];
    const char* cA = (const char*)g.A + (size_t)cur.pm * tstep; const char* cB = (const char*)g.Bt + (size_t)cur.pn * tstep;
    if constexpr (SP2) {
        PG8_STAGE(PG8_SB(0, 0), cB, voffB); PG8_STAGE(PG8_SB(0, 1), cB + hstep, voffB); PG8_STAGE(PG8_SA(0, 0), cA, voffA); PG8_STAGE(PG8_SA(0, 1), cA + hstep, voffA);
        if (wr == 1) PG8_BAR;
        PG8_WAIT_V(2); PG8_BAR;
        PG8_STAGE(PG8_SB(1, 0), cB + kstep, voffB); PG8_STAGE(PG8_SA(1, 0), cA + kstep, voffA); PG8_STAGE(PG8_SB(1, 1), cB + hstep + kstep, voffB);
        PG8_WAIT_V(6); PG8_BAR;
    } else {
        PG8_STAGE(PG8_SB(0, 0), cB, voffB); PG8_STAGE(PG8_SA(0, 0), cA, voffA); PG8_STAGE(PG8_SB(0, 1), cB + hstep, voffB); PG8_STAGE(PG8_SA(0, 1), cA + hstep, voffA);
        if (wr == 1) PG8_BAR;
        PG8_WAIT_V(4); PG8_BAR;
        PG8_STAGE(PG8_SB(1, 0), cB + kstep, voffB); PG8_STAGE(PG8_SA(1, 0), cA + kstep, voffA); PG8_STAGE(PG8_SB(1, 1), cB + hstep + kstep, voffB);
        PG8_WAIT_V(6); PG8_BAR;
    }
    for (;;) {
        const bool has_next = S.next(ui + 1, nxt);
        const char* nA = has_next ? (const char*)g.A + (size_t)nxt.pm * tstep : cA; const char* nB = has_next ? (const char*)g.Bt + (size_t)nxt.pn * tstep : cB;
        for (int t = 0; t < nt; t += 2) {
            const bool last = (t == nt - 2);
            const char* a1 = cA + (size_t)(t + 1) * kstep;
            const char* a2 = last ? nA : cA + (size_t)(t + 2) * kstep; const char* b2 = last ? nB : cB + (size_t)(t + 2) * kstep;
            const char* a3 = a2 + kstep; const char* b3 = b2 + kstep;
            if constexpr (SP2) {
            PG8_LDB(B0, 0, 0); PG8_LDB(B1, 0, 1); PG8_SCHED; PG8_LDA(At, 0, 0); PG8_STAGE(PG8_SA(1, 1), a1 + hstep, voffA);
            PG8_WAIT_V(8); PG8_WAIT_L(0); PG8_BAR; PG8_MMA(0, 0, At, B0); PG8_MMA(0, 1, At, B1); PG8_BAR; PG8_SCHED;
            PG8_LDA(At, 0, 1); PG8_STAGE(PG8_SB(0, 0), b2, voffB); PG8_STAGE(PG8_SB(0, 1), b2 + hstep, voffB); PG8_STAGE(PG8_SA(0, 0), a2, voffA);
            PG8_WAIT_V(8); PG8_WAIT_L(0); PG8_BAR; PG8_MMA(1, 0, At, B0); PG8_MMA(1, 1, At, B1); PG8_BAR; PG8_SCHED;
            PG8_LDB(B0, 1, 0); PG8_LDB(B1, 1, 1); PG8_SCHED; PG8_LDA(At, 1, 0); PG8_STAGE(PG8_SA(0, 1), a2 + hstep, voffA);
            PG8_WAIT_V(8); PG8_WAIT_L(0); PG8_BAR; PG8_MMA(0, 0, At, B0); PG8_MMA(0, 1, At, B1); PG8_BAR; PG8_SCHED;
            PG8_LDA(At, 1, 1); PG8_STAGE(PG8_SB(1, 0), b3, voffB); PG8_STAGE(PG8_SB(1, 1), b3 + hstep, voffB); PG8_STAGE(PG8_SA(1, 0), a3, voffA);
            PG8_WAIT_V(8); PG8_WAIT_L(0); PG8_BAR; PG8_MMA(1, 0, At, B0); PG8_MMA(1, 1, At, B1); PG8_BAR; PG8_SCHED;
            } else {
            PG8_LDB(B0, 0, 0); PG8_SCHED; PG8_LDA(At, 0, 0); PG8_STAGE(PG8_SA(1, 1), a1 + hstep, voffA);
            PG8_WAIT_L(8); PG8_BAR; PG8_WAIT_L(0); PG8_MMA(0, 0, At, B0); PG8_BAR; PG8_SCHED;
            PG8_LDB(B1, 0, 1); PG8_STAGE(PG8_SB(0, 0), b2, voffB);
            PG8_BAR; PG8_WAIT_L(0); PG8_MMA(0, 1, At, B1); PG8_BAR;
            PG8_LDA(At, 0, 1); PG8_STAGE(PG8_SA(0, 0), a2, voffA);
            PG8_BAR; PG8_WAIT_L(0); PG8_MMA(1, 0, At, B0); PG8_BAR; PG8_SCHED;
            PG8_STAGE(PG8_SB(0, 1), b2 + hstep, voffB);
            PG8_WAIT_V(6); PG8_BAR; PG8_MMA(1, 1, At, B1); PG8_BAR;
            PG8_LDB(B0, 1, 0); PG8_SCHED; PG8_LDA(At, 1, 0); PG8_STAGE(PG8_SA(0, 1), a2 + hstep, voffA);
            PG8_WAIT_L(8); PG8_BAR; PG8_WAIT_L(0); PG8_MMA(0, 0, At, B0); PG8_BAR; PG8_SCHED;
            PG8_LDB(B1, 1, 1); PG8_STAGE(PG8_SB(1, 0), b3, voffB);
            PG8_BAR; PG8_WAIT_L(0); PG8_MMA(0, 1, At, B1); PG8_BAR;
            PG8_LDA(At, 1, 1); PG8_STAGE(PG8_SA(1, 0), a3, voffA);
            PG8_BAR; PG8_WAIT_L(0); PG8_MMA(1, 0, At, B0); PG8_BAR; PG8_SCHED;
            PG8_STAGE(PG8_SB(1, 1), b3 + hstep, voffB);
            PG8_WAIT_V(6); PG8_BAR; PG8_MMA(1, 1, At, B1); PG8_BAR;
            }
        }
        if constexpr (ALIGN_EPI) { if (wr == 0) PG8_BAR; }
        E(acc, cur, wr, wc, fr, fq);
        if (!has_next) break;
        if (E.zero_after(cur))
#pragma unroll
        for (int a = 0; a < 2; ++a)
#pragma unroll
            for (int b = 0; b < 2; ++b)
#pragma unroll
                for (int m = 0; m < 4; ++m)
#pragma unroll
                    for (int n = 0; n < 2; ++n) acc[a][b][m][n] = (f32x4){0.f, 0.f, 0.f, 0.f};
        cur = nxt; cA = nA; cB = nB; ++ui;
        if constexpr (ALIGN_EPI) { if (wr == 1) PG8_BAR; }
    }
    PG8_WAIT_V(0);
    if constexpr (!ALIGN_EPI) { if (wr == 0) PG8_BAR; }
    PG8_BAR;
#undef PG8_SA
#undef PG8_SB
#undef PG8_STAGE
#undef PG8_LDA
#undef PG8_LDB
#undef PG8_MMA
#undef PG8_WAIT_V
#undef PG8_WAIT_L
#undef PG8_BAR
#undef PG8_SCHED
}

struct EpiH {
    static constexpr bool PERM = true, PROBE2X = true;
    bf16_t* HM; bf16_t* HG;
    __device__ __forceinline__ bool zero_after(const Unit&) const { return true; }
    __device__ __forceinline__ void operator()(f32x4 (&acc)[2][2][4][2], const Unit& u, int wr, int wc, int fr, int fq) const {
        const int pn = u.pn;
        int act = 0; float scale = 1.f; int colt;
        if (pn < 8) { colt = pn * 256; if (pn >= 4) act = 1; }
        else if (pn < 16) { colt = C_UG + (pn - 8) * 128; act = 3; }
        else if (pn < 20) colt = C_V + (pn - 16) * 256;
        else if (pn < 24) { colt = C_Q + (pn - 20) * 256; scale = 0.125f; }
        else if (pn < 25) colt = C_K;
        else if (pn < 29) { colt = C_CGATE + (pn - 25) * 256; act = 1; }
        else if (pn < 37) { colt = C_GLU + (pn - 29) * 128; act = 4; }
        else { colt = C_DGATE + (pn - 37) * 256; act = 1; }
        if (pn >= 41) {
            const int row0 = u.pm * BM + wr * 64 + fr, d0 = (pn - 41) * 64 + wc * 16 + 4 * fq;
#pragma unroll
            for (int ai = 0; ai < 2; ++ai)
#pragma unroll
                for (int m = 0; m < 4; ++m) { bf16_t* rowp = HG + (size_t)(row0 + ai * HALF + m * 16) * HGW + d0;
                    u32x2 w[4];
#pragma unroll
                    for (int jp = 0; jp < 2; ++jp) { float r[2][4];
#pragma unroll
                        for (int jj = 0; jj < 2; ++jj) { const int j = 2 * jp + jj; float e[4];
#pragma unroll
                            for (int i = 0; i < 4; ++i) e[i] = 1.0f + __expf(-fminf(fmaxf(acc[ai][i >> 1][m][i & 1][j], -30.f), 30.f));
                            r[jj][0] = e[1] * __builtin_amdgcn_rcpf(e[0]); r[jj][1] = e[2] * __builtin_amdgcn_rcpf(e[1]); r[jj][2] = e[3] * __builtin_amdgcn_rcpf(e[2]); r[jj][3] = __builtin_amdgcn_rcpf(e[3]); }
#pragma unroll
                        for (int k = 0; k < 4; ++k) { const unsigned pk = pk2(r[0][k], r[1][k]); if (jp == 0) w[k].x = pk; else w[k].y = pk; } }
#pragma unroll
                    for (int k = 0; k < 4; ++k) *(u32x2*)(rowp + k * 2048) = w[k];
                    asm volatile("" ::: "memory"); }
            return;
        }
        bf16_t* base = HM; const int ldc = HMW;
        if (act >= 3) {
            const int row0 = u.pm * BM + wr * 64 + fr, col0 = colt + wc * 32 + 8 * fq;
#pragma unroll
            for (int ai = 0; ai < 2; ++ai)
#pragma unroll
                for (int m = 0; m < 4; ++m) { bf16_t* rowp = base + (size_t)(row0 + ai * HALF + m * 16) * ldc + col0;
                    f32x4 v0 = acc[ai][0][m][0], v1 = acc[ai][0][m][1]; const f32x4 g0 = acc[ai][1][m][0], g1 = acc[ai][1][m][1];
#pragma unroll
                    for (int j = 0; j < 4; ++j) { const float s0 = sigmoidf_(g0[j]), s1 = sigmoidf_(g1[j]);
                        v0[j] *= (act == 3) ? g0[j] * s0 : s0; v1[j] *= (act == 3) ? g1[j] * s1 : s1; }
                    u32x4 w; w.x = pk2(v0[0], v0[1]); w.y = pk2(v0[2], v0[3]); w.z = pk2(v1[0], v1[1]); w.w = pk2(v1[2], v1[3]);
                    *(u32x4*)rowp = w; }
            return;
        }
        const int row0 = u.pm * BM + wr * 64 + fr, col0 = colt + wc * 32 + 8 * fq;
#pragma unroll
        for (int ai = 0; ai < 2; ++ai)
#pragma unroll
            for (int m = 0; m < 4; ++m) { bf16_t* rowp = base + (size_t)(row0 + ai * HALF + m * 16) * ldc + col0;
#pragma unroll
                for (int bj = 0; bj < 2; ++bj) { f32x4 v0 = acc[ai][bj][m][0] * scale, v1 = acc[ai][bj][m][1] * scale;
                    if (act == 1) {
#pragma unroll
                        for (int j = 0; j < 4; ++j) { v0[j] = siluf_(v0[j]); v1[j] = siluf_(v1[j]); } }
                    u32x4 w; w.x = pk2(v0[0], v0[1]); w.y = pk2(v0[2], v0[3]); w.z = pk2(v1[0], v1[1]); w.w = pk2(v1[2], v1[3]);
                    *(u32x4*)(rowp + bj * HALF) = w; } }
    }
};
struct EpiPool {
    static constexpr bool PERM = true, PROBE2X = false;
    const bf16_t* HM; bf16_t* YA;
    __device__ __forceinline__ bool zero_after(const Unit&) const { return true; }
    __device__ __forceinline__ void operator()(f32x4 (&acc)[2][2][4][2], const Unit& u, int wr, int wc, int fr, int fq) const {
        const int g = u.pm >> 6; const int row0 = (u.pm & 63) * BM + wr * 64 + fr, col0 = g * 256 + wc * 32 + 8 * fq;
#pragma unroll
        for (int ai = 0; ai < 2; ++ai)
#pragma unroll
            for (int m = 0; m < 4; ++m) { const size_t row = (size_t)(row0 + ai * HALF + m * 16);
#pragma unroll
                for (int bj = 0; bj < 2; ++bj) { const int col = col0 + bj * HALF;
                    const u32x4 gt = *(const u32x4*)(HM + row * HMW + C_AGATE + col);
                    const f32x4 v0 = acc[ai][bj][m][0], v1 = acc[ai][bj][m][1];
                    u32x4 w; w.x = pk2(v0[0] * bflo(gt.x), v0[1] * bfhi(gt.x)); w.y = pk2(v0[2] * bflo(gt.y), v0[3] * bfhi(gt.y));
                    w.z = pk2(v1[0] * bflo(gt.z), v1[1] * bfhi(gt.z)); w.w = pk2(v1[2] * bflo(gt.w), v1[3] * bfhi(gt.w));
                    *(u32x4*)(YA + row * 1024 + col) = w; } }
    }
};
struct EpiBr {
    static constexpr bool PERM = true, PROBE2X = false;
    const bf16_t* HG; bf16_t* MG;
    __device__ __forceinline__ bool zero_after(const Unit& u) const { return (u.pm >> 6) == 3; }
    __device__ __forceinline__ void operator()(f32x4 (&acc)[2][2][4][2], const Unit& u, int wr, int wc, int fr, int fq) const {
        const int br = u.pm >> 6; const int row0 = (u.pm & 63) * BM + wr * 64 + fr, col0 = (u.pn & 7) * BM + wc * 32 + 8 * fq;
#pragma unroll
        for (int ai = 0; ai < 2; ++ai)
#pragma unroll
            for (int m = 0; m < 4; ++m) { const size_t row = (size_t)(row0 + ai * HALF + m * 16);
#pragma unroll
                for (int bj = 0; bj < 2; ++bj) { const int col = col0 + bj * HALF;
                    const u32x4 gt = *(const u32x4*)(HG + row * HGW + br * 2048 + col);
                    f32x4 v0 = acc[ai][bj][m][0], v1 = acc[ai][bj][m][1];
                    v0[0] *= bflo(gt.x); v0[1] *= bfhi(gt.x); v0[2] *= bflo(gt.y); v0[3] *= bfhi(gt.y);
                    v1[0] *= bflo(gt.z); v1[1] *= bfhi(gt.z); v1[2] *= bflo(gt.w); v1[3] *= bfhi(gt.w);
                    if (br < 3) { acc[ai][bj][m][0] = v0; acc[ai][bj][m][1] = v1; }
                    else { u32x4 w; w.x = pk2(v0[0], v0[1]); w.y = pk2(v0[2], v0[3]); w.z = pk2(v1[0], v1[1]); w.w = pk2(v1[2], v1[3]); *(u32x4*)(MG + row * DM + col) = w; } } }
    }
};
struct EpiOut {
    static constexpr bool PERM = false, PROBE2X = false;
    const float* xres; float* out;
    __device__ __forceinline__ bool zero_after(const Unit&) const { return true; }
    __device__ __forceinline__ void operator()(f32x4 (&acc)[2][2][4][2], const Unit& u, int wr, int wc, int fr, int fq) const {
        const int row0 = u.pm * BM + wr * 64 + fr, col0 = u.pn * BM + wc * 32 + 4 * fq;
#pragma unroll
        for (int ai = 0; ai < 2; ++ai)
#pragma unroll
            for (int m = 0; m < 4; ++m) { const size_t ro = (size_t)(row0 + ai * HALF + m * 16) * DM + col0;
#pragma unroll
                for (int bj = 0; bj < 2; ++bj)
#pragma unroll
                    for (int n = 0; n < 2; ++n) { const f32x4 xr = *(const f32x4*)(xres + ro + bj * HALF + n * 16);
                        *(f32x4*)(out + ro + bj * HALF + n * 16) = xr * ALPHA + acc[ai][bj][m][n]; } }
    }
};
}

__device__ __forceinline__ void p0_transpose_item(const float* W, int K, int N, bf16_t* WT, LAS float* scr, int item, int lane, const float* nscale = nullptr, bool gate_remap = false) {
    const int nblk = N / 32, kb = item / nblk, nb = item % nblk, k0 = 64 * kb, n0 = 32 * nb;
#pragma unroll 8
    for (int i = 0; i < 32; ++i) { const int kk = 2 * i + (lane >> 5); scr[kk * 33 + (lane & 31)] = W[(size_t)(k0 + kk) * N + n0 + (lane & 31)]; }
    asm volatile("s_waitcnt lgkmcnt(0)" ::: "memory");
    const int c = lane & 7;
#pragma unroll
    for (int j = 0; j < 4; ++j) { const int n = (lane >> 3) + 8 * j; const LAS float* s = scr + (8 * c) * 33 + n;
        const float sc = nscale ? nscale[n0 + n] : 1.0f;
        u32x4 o; o.x = pk2(s[0 * 33] * sc, s[1 * 33] * sc); o.y = pk2(s[2 * 33] * sc, s[3 * 33] * sc); o.z = pk2(s[4 * 33] * sc, s[5 * 33] * sc); o.w = pk2(s[6 * 33] * sc, s[7 * 33] * sc);
        int orow = n0 + n;
        if (gate_remap) {
            const int n_ = orow;
            if (n_ >= NMIX) { const int g = n_ - NMIX, i = g >> 11, d = g & 2047, dl = d & 63;
                orow = NMIX + (d >> 6) * 256 + 128 * (i >> 1) + 32 * (dl >> 4) + 8 * ((dl >> 2) & 3) + 4 * (i & 1) + (dl & 3); }
            else if (n_ >= 2048 && n_ < 3072) { const int ch = n_ - 2048; orow = (8 + (ch >> 7)) * 256 + (ch & 127); }
            else if (n_ >= 3072 && n_ < 4096) orow = 16 * 256 + (n_ - 3072);
            else if (n_ >= 4096 && n_ < 5120) { const int ch = n_ - 4096; orow = (8 + (ch >> 7)) * 256 + 128 + (ch & 127); }
            else if (n_ >= 7424 && n_ < 8448) { const int ch = n_ - 7424; orow = (29 + (ch >> 7)) * 256 + (ch & 127); }
            else if (n_ >= 8448 && n_ < 9472) { const int ch = n_ - 8448; orow = (29 + (ch >> 7)) * 256 + 128 + (ch & 127); } }
        *(u32x4*)(WT + (size_t)orow * K + k0 + 8 * c) = o; }
    asm volatile("s_waitcnt lgkmcnt(0)" ::: "memory");
}
__device__ __forceinline__ void phase_p0(KP p, LAS unsigned char* lds) {
    int tid_ = threadIdx.x; OPAQUE_V(tid_); const int tid = tid_, wid = tid >> 6, lane = tid & 63;
    LAS float* scr = (LAS float*)(lds + wid * 16384);
    const int gw = blockIdx.x * 8 + wid, NGW = gridDim.x * 8;
    constexpr int I_IN = 32 * 584, I_BR = 16 * 64, I_OUT = 32 * 64, I_PW = 4 * 8, PER_L = I_IN + 4 * I_BR + I_OUT + 4 * I_PW;
    for (int it = gw; it < 2 * PER_L; it += NGW) {
        const int l = it / PER_L; int r = it % PER_L;
        if (r < I_IN) { p0_transpose_item(p->in[1] + (size_t)l * DM * DIN, DM, DIN, (bf16_t*)(p->ws + WS_WIN + l * SZ_WIN), scr, r, lane, nullptr, true); continue; } r -= I_IN;
        if (r < 4 * I_BR) { const int i = r / I_BR; p0_transpose_item(p->in[14] + (size_t)(l * 4 + i) * 1024 * 2048, 1024, 2048, (bf16_t*)(p->ws + WS_WB) + (size_t)(l * 4 + i) * 2048 * 1024, scr, r % I_BR, lane); continue; } r -= 4 * I_BR;
        if (r < I_OUT) { p0_transpose_item(p->in[15] + (size_t)l * 2048 * 2048, 2048, 2048, (bf16_t*)(p->ws + WS_WO) + (size_t)l * 2048 * 2048, scr, r, lane); continue; } r -= I_OUT;
        { const int g = r / I_PW; p0_transpose_item(p->in[2] + (size_t)(l * 4 + g) * 256 * 256, 256, 256, (bf16_t*)(p->ws + WS_WP) + (size_t)(l * 4 + g) * 256 * 256, scr, r % I_PW, lane, p->in[3] + l * 1024 + g * 256); }
    }
    const float* x = p->in[0]; bf16_t* xb = (bf16_t*)(p->ws + WS_XB);
    const size_t n8 = (size_t)SEQ * DM / 8;
    for (size_t i = (size_t)blockIdx.x * 512 + tid; i < n8; i += (size_t)gridDim.x * 512) {
        const f32x4 a = *(const f32x4*)(x + i * 8), b = *(const f32x4*)(x + i * 8 + 4);
        u32x4 w; w.x = pk2(a[0], a[1]); w.y = pk2(a[2], a[3]); w.z = pk2(b[0], b[1]); w.w = pk2(b[2], b[3]);
        *(u32x4*)(xb + i * 8) = w;
    }
    __syncthreads();
}

__device__ __forceinline__ void attn_item(KP p, LAS unsigned char* lds, int l, int n, int hk) {
    int tid_ = threadIdx.x; OPAQUE_V(tid_);
    const int tid = tid_, wid = __builtin_amdgcn_readfirstlane(tid >> 6), lane = tid & 63, fr = lane & 15, fq = lane >> 4;
    const bf16_t* HM = (const bf16_t*)(p->ws + WS_HM);
    bf16_t* YC = (bf16_t*)(p->ws + WS_Y) + (size_t)2 * SEQ * 1024;
    LAS bf16_t* Ks = (LAS bf16_t*)lds;
    LAS unsigned* Vt32 = (LAS unsigned*)(lds + 36864);
    LAS float* bias = (LAS float*)(lds + 36864 + 35840);
    const int tokb = (n - 1) * 128;
    for (int idx = tid; idx < 2048; idx += 512) { const int key = idx >> 3, pc = idx & 7; const int tok = tokb + key;
        u32x4 v = (u32x4){0u, 0u, 0u, 0u}; if (tok >= 0) v = *(const u32x4*)(HM + (size_t)tok * HMW + C_K + hk * 64 + pc * 8);
        *(LAS u32x4*)(Ks + key * 72 + pc * 8) = v; }
    for (int idx = tid; idx < 1024; idx += 512) { const int p2 = idx & 127, dg = idx >> 7; const int tok0 = tokb + 2 * p2;
        u32x4 a = (u32x4){0u, 0u, 0u, 0u}, b = a;
        if (tok0 >= 0) { a = *(const u32x4*)(HM + (size_t)tok0 * HMW + C_VV + hk * 64 + dg * 8); b = *(const u32x4*)(HM + (size_t)(tok0 + 1) * HMW + C_VV + hk * 64 + dg * 8); }
        LAS unsigned* o = Vt32 + (dg * 8) * 140 + p2;
        o[0 * 140] = (a.x & 0xffffu) | (b.x << 16); o[1 * 140] = (a.x >> 16) | (b.x & 0xffff0000u);
        o[2 * 140] = (a.y & 0xffffu) | (b.y << 16); o[3 * 140] = (a.y >> 16) | (b.y & 0xffff0000u);
        o[4 * 140] = (a.z & 0xffffu) | (b.z << 16); o[5 * 140] = (a.z >> 16) | (b.z & 0xffff0000u);
        o[6 * 140] = (a.w & 0xffffu) | (b.w << 16); o[7 * 140] = (a.w >> 16) | (b.w & 0xffff0000u); }
    for (int idx = tid; idx < 768; idx += 512) Vt32[(idx / 12) * 140 + 128 + (idx % 12)] = 0u;
    for (int idx = tid; idx < 1024; idx += 512) { const int w = idx >> 7, d = idx & 127; bias[idx] = p->in[9][(int)T5_BUCKET[d] * 16 + hk * 8 + w]; }
    __syncthreads();
    const int h = hk * 8 + wid;
    const float sink = p->in[8][l * 16 + h];
    const LAS float* bh = bias + wid * 128;
    float bv[9][4];
#pragma unroll
    for (int k9 = 0; k9 < 9; ++k9)
#pragma unroll
        for (int j = 0; j < 4; ++j) { const int dist = 128 - 16 * k9 + fr - fq * 4 - j; bv[k9][j] = (dist >= 0 && dist < 128) ? bh[dist & 127] : -1e30f; }
    bf16x8 qn0, qn1;
    { const bf16_t* qrow = HM + (size_t)(n * 128 + fr) * HMW + C_Q + h * 64 + fq * 8; qn0 = *(const bf16x8*)qrow; qn1 = *(const bf16x8*)(qrow + 32); }
#pragma unroll 1
    for (int qt = 0; qt < 8; ++qt) {
        const int tok = n * 128 + qt * 16 + fr;
        const bf16x8 q0 = qn0, q1 = qn1;
        { const int tokn = n * 128 + (qt < 7 ? qt + 1 : qt) * 16 + fr; const bf16_t* qrow = HM + (size_t)tokn * HMW + C_Q + h * 64 + fq * 8; qn0 = *(const bf16x8*)qrow; qn1 = *(const bf16x8*)(qrow + 32); }
        u32x2 cg4[4];
#pragma unroll
        for (int dt = 0; dt < 4; ++dt) cg4[dt] = *(const u32x2*)(HM + (size_t)tok * HMW + C_CGATE + h * 64 + dt * 16 + fq * 4);
        f32x4 s[10];
#pragma unroll
        for (int k9 = 0; k9 < 9; ++k9) { const LAS bf16_t* kp = Ks + ((qt + k9) * 16 + fr) * 72 + fq * 8;
            f32x4 z = (f32x4){0.f, 0.f, 0.f, 0.f};
            z = mfma16(*(const LAS bf16x8*)kp, q0, z); z = mfma16(*(const LAS bf16x8*)(kp + 32), q1, z); s[k9] = z; }
        s[9] = (f32x4){0.f, 0.f, 0.f, 0.f};
        float mx = sink;
#pragma unroll
        for (int k9 = 0; k9 < 9; ++k9)
#pragma unroll
            for (int j = 0; j < 4; ++j) { float lg = s[k9][j] + bv[k9][j];
                if (n == 0 && (qt + k9) * 16 + fq * 4 + j < 128) lg = -1e30f;
                s[k9][j] = lg; mx = fmaxf(mx, lg); }
        mx = fmaxf(mx, __shfl_xor(mx, 16)); mx = fmaxf(mx, __shfl_xor(mx, 32));
        float sum = 0.f;
#pragma unroll
        for (int k9 = 0; k9 < 9; ++k9)
#pragma unroll
            for (int j = 0; j < 4; ++j) { const float e = __expf(s[k9][j] - mx); s[k9][j] = e; sum += e; }
        sum += __shfl_xor(sum, 16); sum += __shfl_xor(sum, 32); sum += __expf(sink - mx);
        const float inv = 1.0f / sum;
        f32x4 o[4];
#pragma unroll
        for (int dt = 0; dt < 4; ++dt) o[dt] = (f32x4){0.f, 0.f, 0.f, 0.f};
#pragma unroll
        for (int pr = 0; pr < 5; ++pr) {
            u32x4 pw; pw.x = pk2(s[2 * pr][0], s[2 * pr][1]); pw.y = pk2(s[2 * pr][2], s[2 * pr][3]); pw.z = pk2(s[2 * pr + 1][0], s[2 * pr + 1][1]); pw.w = pk2(s[2 * pr + 1][2], s[2 * pr + 1][3]);
            const bf16x8 pf = __builtin_bit_cast(bf16x8, pw);
#pragma unroll
            for (int dt = 0; dt < 4; ++dt) { const LAS unsigned* vp = Vt32 + (dt * 16 + fr) * 140 + (qt + 2 * pr) * 8 + fq * 2;
                const u32x2 lo = *(const LAS u32x2*)vp, hi = *(const LAS u32x2*)(vp + 8);
                u32x4 aw; aw.x = lo.x; aw.y = lo.y; aw.z = hi.x; aw.w = hi.y;
                o[dt] = mfma16(__builtin_bit_cast(bf16x8, aw), pf, o[dt]); } }
#pragma unroll
        for (int dt = 0; dt < 4; ++dt) { const int col = h * 64 + dt * 16 + fq * 4;
            const u32x2 gt = cg4[dt];
            u32x2 w; w.x = pk2(o[dt][0] * inv * bflo(gt.x), o[dt][1] * inv * bfhi(gt.x)); w.y = pk2(o[dt][2] * inv * bflo(gt.y), o[dt][3] * inv * bfhi(gt.y));
            *(u32x2*)(YC + (size_t)tok * 1024 + col) = w; }
    }
    __syncthreads();
}

__device__ __forceinline__ void sgu_item(KP p, LAS unsigned char* lds, int l, int n) {
    int tid_ = threadIdx.x; OPAQUE_V(tid_);
    const int tid = tid_, wid = __builtin_amdgcn_readfirstlane(tid >> 6), lane = tid & 63, fr = lane & 15, fq = lane >> 4;
    const bf16_t* HM = (const bf16_t*)(p->ws + WS_HM);
    bf16_t* YB = (bf16_t*)(p->ws + WS_Y) + (size_t)1 * SEQ * 1024;
    LAS bf16_t* vnT = (LAS bf16_t*)lds;
    LAS unsigned* vnT32 = (LAS unsigned*)lds;
    LAS float* stats = (LAS float*)(lds + 139264);
    const float* lng = p->in[4] + l * 1024; const float* lnb = p->in[5] + l * 1024;
#pragma unroll 1
    for (int tb = 0; tb < 16; tb += 4) {
        u32x4 a[4], b[4];
#pragma unroll
        for (int q = 0; q < 4; ++q) { const bf16_t* row = HM + (size_t)(n * 128 + wid * 16 + tb + q) * HMW + C_V; a[q] = *(const u32x4*)(row + lane * 8); b[q] = *(const u32x4*)(row + 512 + lane * 8); }
        float mean[4], rstd[4];
#pragma unroll
        for (int q = 0; q < 4; ++q) { const float sm = ((bflo(a[q].x) + bfhi(a[q].x)) + (bflo(a[q].y) + bfhi(a[q].y))) + ((bflo(a[q].z) + bfhi(a[q].z)) + (bflo(a[q].w) + bfhi(a[q].w)))
                + ((bflo(b[q].x) + bfhi(b[q].x)) + (bflo(b[q].y) + bfhi(b[q].y))) + ((bflo(b[q].z) + bfhi(b[q].z)) + (bflo(b[q].w) + bfhi(b[q].w)));
            mean[q] = sm; }
#pragma unroll
        for (int o = 1; o < 64; o <<= 1) {
#pragma unroll
            for (int q = 0; q < 4; ++q) mean[q] += __shfl_xor(mean[q], o); }
#pragma unroll
        for (int q = 0; q < 4; ++q) { mean[q] *= (1.f / 1024.f); const float m = mean[q];
            const float d0 = bflo(a[q].x) - m, d1 = bfhi(a[q].x) - m, d2 = bflo(a[q].y) - m, d3 = bfhi(a[q].y) - m, d4 = bflo(a[q].z) - m, d5 = bfhi(a[q].z) - m, d6 = bflo(a[q].w) - m, d7 = bfhi(a[q].w) - m;
            const float e0 = bflo(b[q].x) - m, e1 = bfhi(b[q].x) - m, e2 = bflo(b[q].y) - m, e3 = bfhi(b[q].y) - m, e4 = bflo(b[q].z) - m, e5 = bfhi(b[q].z) - m, e6 = bflo(b[q].w) - m, e7 = bfhi(b[q].w) - m;
            rstd[q] = ((d0 * d0 + d1 * d1) + (d2 * d2 + d3 * d3)) + ((d4 * d4 + d5 * d5) + (d6 * d6 + d7 * d7)) + ((e0 * e0 + e1 * e1) + (e2 * e2 + e3 * e3)) + ((e4 * e4 + e5 * e5) + (e6 * e6 + e7 * e7)); }
#pragma unroll
        for (int o = 1; o < 64; o <<= 1) {
#pragma unroll
            for (int q = 0; q < 4; ++q) rstd[q] += __shfl_xor(rstd[q], o); }
        if (lane == 0) {
#pragma unroll
            for (int q = 0; q < 4; ++q) { stats[(wid * 16 + tb + q) * 2] = mean[q]; stats[(wid * 16 + tb + q) * 2 + 1] = rsqrtf(rstd[q] * (1.f / 1024.f) + LN_EPS); } }
    }
    __syncthreads();
#pragma unroll 1
    for (int r = 0; r < 2; ++r) {
        {
            const float m0 = stats[4 * lane], r0 = stats[4 * lane + 1], m1 = stats[4 * lane + 2], r1 = stats[4 * lane + 3];
#pragma unroll 1
            for (int ib = 0; ib < 8; ib += 2) {
                u32x4 ra[2], rb[2];
#pragma unroll
                for (int it = 0; it < 2; ++it) { const int dg = wid + 8 * (ib + it); const bf16_t* row = HM + (size_t)(n * 128 + 2 * lane) * HMW + C_V + r * 512 + dg * 8;
                    ra[it] = *(const u32x4*)row; rb[it] = *(const u32x4*)(row + HMW); }
#pragma unroll
                for (int it = 0; it < 2; ++it) { const int dg = wid + 8 * (ib + it), d0 = dg * 8, col = r * 512 + d0;
                    const f32x4 g0 = *(const f32x4*)(lng + col), g1 = *(const f32x4*)(lng + col + 4), b0 = *(const f32x4*)(lnb + col), b1 = *(const f32x4*)(lnb + col + 4);
                    const u32x4 a = ra[it], b = rb[it];
                    const float av[8] = {bflo(a.x), bfhi(a.x), bflo(a.y), bfhi(a.y), bflo(a.z), bfhi(a.z), bflo(a.w), bfhi(a.w)};
                    const float bv[8] = {bflo(b.x), bfhi(b.x), bflo(b.y), bfhi(b.y), bflo(b.z), bfhi(b.z), bflo(b.w), bfhi(b.w)};
                    const float gv[8] = {g0[0], g0[1], g0[2], g0[3], g1[0], g1[1], g1[2], g1[3]};
                    const float cv[8] = {b0[0], b0[1], b0[2], b0[3], b1[0], b1[1], b1[2], b1[3]};
                    LAS unsigned* o = vnT32 + ((d0 >> 7) * 128 + (d0 & 127)) * 68 + lane;
#pragma unroll
                    for (int i = 0; i < 8; ++i) o[i * 68] = pk2((av[i] - m0) * r0 * gv[i] + cv[i], (bv[i] - m1) * r1 * gv[i] + cv[i]); }
            }
        }
        __syncthreads();
        const int hl = wid >> 1, th = wid & 1, h = 4 * r + hl;
        const float* wbase = p->in[6] + (size_t)(l * 8 + h) * 128 * 128;
#pragma unroll 1
        for (int tti = 0; tti < 4; ++tti) {
            const int t0 = (th * 4 + tti) * 16, t = t0 + fr;
            const int nks = (t0 >> 5) + 1;
            const size_t tok = (size_t)n * 128 + t;
            f32x4 w0[4], w1[4];
#pragma unroll
            for (int ks = 0; ks < 4; ++ks) { w0[ks] = (f32x4){0.f, 0.f, 0.f, 0.f}; w1[ks] = w0[ks];
                if (ks < nks) { const float* wp = wbase + t * 128 + ks * 32 + fq * 8; w0[ks] = *(const f32x4*)wp; w1[ks] = *(const f32x4*)(wp + 4); } }
            u32x2 uu[8];
#pragma unroll
            for (int dt = 0; dt < 8; ++dt) { const int col = h * 128 + dt * 16 + fq * 4; uu[dt] = *(const u32x2*)(HM + tok * HMW + C_UG + col); }
            const float bs = p->in[7][(l * 8 + h) * 128 + t];
            f32x4 acc[8];
#pragma unroll
            for (int dt = 0; dt < 8; ++dt) acc[dt] = (f32x4){0.f, 0.f, 0.f, 0.f};
#pragma unroll
            for (int ks = 0; ks < 4; ++ks) if (ks < nks) { const int s0 = ks * 32 + fq * 8;
                u32x4 bw;
                bw.x = pk2(s0 + 0 <= t ? w0[ks][0] : 0.f, s0 + 1 <= t ? w0[ks][1] : 0.f); bw.y = pk2(s0 + 2 <= t ? w0[ks][2] : 0.f, s0 + 3 <= t ? w0[ks][3] : 0.f);
                bw.z = pk2(s0 + 4 <= t ? w1[ks][0] : 0.f, s0 + 5 <= t ? w1[ks][1] : 0.f); bw.w = pk2(s0 + 6 <= t ? w1[ks][2] : 0.f, s0 + 7 <= t ? w1[ks][3] : 0.f);
                const bf16x8 bf = __builtin_bit_cast(bf16x8, bw);
#pragma unroll
                for (int dt = 0; dt < 8; ++dt) { const bf16x8 af = *(const LAS bf16x8*)(vnT + (hl * 128 + dt * 16 + fr) * 136 + s0);
                    acc[dt] = mfma16(af, bf, acc[dt]); } }
#pragma unroll
            for (int dt = 0; dt < 8; ++dt) { const int col = h * 128 + dt * 16 + fq * 4;
                u32x2 w; w.x = pk2((acc[dt][0] + bs) * bflo(uu[dt].x), (acc[dt][1] + bs) * bfhi(uu[dt].x));
                w.y = pk2((acc[dt][2] + bs) * bflo(uu[dt].y), (acc[dt][3] + bs) * bfhi(uu[dt].y));
                *(u32x2*)(YB + tok * 1024 + col) = w; }
        }
        __syncthreads();
    }
}

__device__ __forceinline__ f32x2 glu_at(const bf16_t* hm, int tok) {
    f32x2 g = (f32x2){0.f, 0.f};
    if (tok >= 0) { const unsigned va = *(const unsigned*)(hm + (size_t)tok * HMW + C_GLU); g = (f32x2){bflo(va), bfhi(va)}; }
    return g;
}
__device__ __forceinline__ void conv_item(KP p, LAS unsigned char* lds, int l, int tile) {
    int tid_ = threadIdx.x; OPAQUE_V(tid_);
    const int tid = tid_, wid = __builtin_amdgcn_readfirstlane(tid >> 6), lane = tid & 63;
    const bf16_t* HM = (const bf16_t*)(p->ws + WS_HM);
    bf16_t* YD = (bf16_t*)(p->ws + WS_Y) + (size_t)3 * SEQ * 1024;
    LAS float* ybuf = (LAS float*)lds;
    const int t0 = tile * 32, c0 = 2 * tid;
    const bf16_t* hm = HM + c0;
    f32x2 w[31];
#pragma unroll
    for (int j = 0; j < 31; ++j) w[j] = *(const f32x2*)(p->in[10] + (size_t)(l * 31 + j) * 1024 + c0);
    const f32x2 cb = *(const f32x2*)(p->in[11] + l * 1024 + c0);
    f32x2 g[34];
#pragma unroll
    for (int i = 0; i < 30; ++i) g[i] = glu_at(hm, t0 - 30 + i);
    unsigned nv[4];
#pragma unroll
    for (int q = 0; q < 4; ++q) nv[q] = *(const unsigned*)(hm + (size_t)(t0 + q) * HMW + C_GLU);
#pragma unroll 1
    for (int blk = 0; blk < 8; ++blk) {
#pragma unroll
        for (int q = 0; q < 4; ++q) g[30 + q] = (f32x2){bflo(nv[q]), bfhi(nv[q])};
        { const int tn = t0 + (blk < 7 ? blk + 1 : blk) * 4;
#pragma unroll
          for (int q = 0; q < 4; ++q) nv[q] = *(const unsigned*)(hm + (size_t)(tn + q) * HMW + C_GLU); }
        f32x2 y[4] = {cb, cb, cb, cb};
#pragma unroll
        for (int j = 0; j < 31; ++j)
#pragma unroll
            for (int q = 0; q < 4; ++q) y[q] += w[j] * g[q + j];
#pragma unroll
        for (int q = 0; q < 4; ++q) *(LAS f32x2*)(ybuf + (blk * 4 + q) * 1024 + c0) = y[q];
#pragma unroll
        for (int i = 0; i < 30; ++i) g[i] = g[i + 4];
    }
    __syncthreads();
    const float* lng = p->in[12] + l * 1024; const float* lnb = p->in[13] + l * 1024;
    for (int tt = 0; tt < 4; ++tt) { const int o = wid * 4 + tt; const size_t tok = (size_t)t0 + o;
        f32x4 v[4]; float sm = 0.f;
#pragma unroll
        for (int j = 0; j < 4; ++j) { v[j] = *(const LAS f32x4*)(ybuf + o * 1024 + lane * 4 + 256 * j); sm += (v[j][0] + v[j][1]) + (v[j][2] + v[j][3]); }
        const float mean = wave_sum(sm) * (1.f / 1024.f); float sq = 0.f;
#pragma unroll
        for (int j = 0; j < 4; ++j) { v[j] = v[j] - mean; sq += (v[j][0] * v[j][0] + v[j][1] * v[j][1]) + (v[j][2] * v[j][2] + v[j][3] * v[j][3]); }
        const float rstd = rsqrtf(wave_sum(sq) * (1.f / 1024.f) + LN_EPS);
#pragma unroll
        for (int j = 0; j < 4; ++j) { const int c = lane * 4 + 256 * j;
            const f32x4 gg = *(const f32x4*)(lng + c), bb = *(const f32x4*)(lnb + c);
            const u32x2 gt = *(const u32x2*)(HM + tok * HMW + C_DGATE + c);
            const f32x4 y = v[j] * rstd * gg + bb;
            u32x2 wv; wv.x = pk2(siluf_(y[0]) * bflo(gt.x), siluf_(y[1]) * bfhi(gt.x)); wv.y = pk2(siluf_(y[2]) * bflo(gt.y), siluf_(y[3]) * bfhi(gt.y));
            *(u32x2*)(YD + tok * 1024 + c) = wv; } }
    __syncthreads();
}

__device__ __forceinline__ void pool_item(KP p, int n) {
    int tid_ = threadIdx.x; OPAQUE_V(tid_); const int tid = tid_;
    const bf16_t* HM = (const bf16_t*)(p->ws + WS_HM);
    bf16_t* MIX = (bf16_t*)(p->ws + WS_MIX);
    const int c = (tid & 127) * 8, tq = tid >> 7, g = c >> 8, w = 2 << g;
    const int ts = n * 128 + tq * 32;
    float s[8];
#pragma unroll
    for (int i = 0; i < 8; ++i) s[i] = 0.f;
    for (int tau = 1; tau <= w; ++tau) { const int tok = ts - tau; if (tok >= 0) { const u32x4 a = *(const u32x4*)(HM + (size_t)tok * HMW + C_AIN + c);
            s[0] += bflo(a.x); s[1] += bfhi(a.x); s[2] += bflo(a.y); s[3] += bfhi(a.y); s[4] += bflo(a.z); s[5] += bfhi(a.z); s[6] += bflo(a.w); s[7] += bfhi(a.w); } }
#pragma unroll 1
    for (int tb = ts; tb < ts + 32; tb += 8) {
        u32x4 av[8], bv[8];
#pragma unroll
        for (int q = 0; q < 8; ++q) { const int t = tb + q; av[q] = *(const u32x4*)(HM + (size_t)t * HMW + C_AIN + c);
            bv[q] = (u32x4){0u, 0u, 0u, 0u}; if (t - w >= 0) bv[q] = *(const u32x4*)(HM + (size_t)(t - w) * HMW + C_AIN + c); }
#pragma unroll
        for (int q = 0; q < 8; ++q) { const int t = tb + q; const u32x4 a = av[q], b = bv[q];
            const float cur[8] = {bflo(a.x), bfhi(a.x), bflo(a.y), bfhi(a.y), bflo(a.z), bfhi(a.z), bflo(a.w), bfhi(a.w)};
            const float old[8] = {bflo(b.x), bfhi(b.x), bflo(b.y), bfhi(b.y), bflo(b.z), bfhi(b.z), bflo(b.w), bfhi(b.w)};
            const float rc = 1.0f / (float)(t + 1 < w ? t + 1 : w);
            float m[8];
#pragma unroll
            for (int i = 0; i < 8; ++i) { s[i] = s[i] + cur[i] - old[i]; m[i] = s[i] * rc - cur[i]; }
            u32x4 o; o.x = pk2(m[0], m[1]); o.y = pk2(m[2], m[3]); o.z = pk2(m[4], m[5]); o.w = pk2(m[6], m[7]);
            *(u32x4*)(MIX + ((size_t)g * SEQ + t) * 256 + (c & 255)) = o; }
    }
}

#ifndef GEMM_ALIGN
#define GEMM_ALIGN true
#endif
#ifndef GEMM_SP2
#define GEMM_SP2 true
#endif
constexpr int GEMM1_EXTRA = 64;
constexpr int CW_QUEUE = 3584;
__device__ __forceinline__ void phase_mixers(KP p, LAS unsigned char* lds, int l) {
    unsigned* head = (unsigned*)(p->ws + WS_CTL) + CW_QUEUE + 64 * l;
    volatile LAS unsigned* qslot = (volatile LAS unsigned*)(lds + LDS_BYTES - 64) + 8;
    for (;;) {
        __syncthreads();
        if (threadIdx.x == 0) qslot[0] = __hip_atomic_fetch_add(head, 1u, __ATOMIC_RELAXED, __HIP_MEMORY_SCOPE_AGENT);
        __syncthreads();
        const int it = __builtin_amdgcn_readfirstlane((int)qslot[0]);
        if (it >= 1088) break;
        if (it < 64) {
            unsigned char* ws = p->ws;
            pg8::Gemm g{(const bf16_t*)(ws + WS_XB), (const bf16_t*)(ws + WS_WIN + l * SZ_WIN), SEQ, DIN, DM};
            pg8::ExtraOrder S{it, DIN / 256 - 1};
            pg8::EpiH E{(bf16_t*)(ws + WS_HM), (bf16_t*)(ws + WS_HG)};
            pg8::gemm_phase<GEMM_ALIGN, GEMM_SP2>(lds, g, S, E);
        }
        else if (it < 192) sgu_item(p, lds, l, it - 64);
        else if (it < 448) attn_item(p, lds, l, (it - 192) >> 1, (it - 192) & 1);
        else if (it < 960) conv_item(p, lds, l, it - 448);
        else pool_item(p, it - 960);
    }
}

__device__ __forceinline__ void phase_ln(KP p, int l) {
    int tid_ = threadIdx.x; OPAQUE_V(tid_); const int tid = tid_, wid = tid >> 6, lane = tid & 63;
    const float* lng = p->in[16] + l * DM; const float* lnb = p->in[17] + l * DM;
    bf16_t* xb = (bf16_t*)(p->ws + WS_XB);
    for (int row = blockIdx.x * 8 + wid; row < SEQ; row += gridDim.x * 8) {
        float* xr = p->out + (size_t)row * DM + lane * 4;
        f32x4 v[8]; float sm = 0.f;
#pragma unroll
        for (int j = 0; j < 8; ++j) { v[j] = *(const f32x4*)(xr + 256 * j); sm += (v[j][0] + v[j][1]) + (v[j][2] + v[j][3]); }
        const float mean = wave_sum(sm) * (1.f / DM); float sq = 0.f;
#pragma unroll
        for (int j = 0; j < 8; ++j) { v[j] = v[j] - mean; sq += (v[j][0] * v[j][0] + v[j][1] * v[j][1]) + (v[j][2] * v[j][2] + v[j][3] * v[j][3]); }
        const float rstd = rsqrtf(wave_sum(sq) * (1.f / DM) + LN_EPS);
#pragma unroll
        for (int j = 0; j < 8; ++j) { const int c = lane * 4 + 256 * j;
            const f32x4 y = v[j] * rstd * *(const f32x4*)(lng + c) + *(const f32x4*)(lnb + c);
            *(f32x4*)(xr + 256 * j) = y;
            if (l + 1 < DEPTH) { u32x2 wv; wv.x = pk2(y[0], y[1]); wv.y = pk2(y[2], y[3]); *(u32x2*)(xb + (size_t)row * DM + c) = wv; } }
    }
}


#define XB_TMO      128
#define XB_XCNT(j)  (256  + 64 * (j))
#define XB_XSUB(j)  (1280 + 64 * (j))
#define XB_XGEN(j)  (2304 + 64 * (j))
#define XB_TOP      3328
#define XB_TOPGEN   3392
#define XCD_BAR_WORDS 3456
#define XB_SPIN_CAP (1u << 18)
__device__ __forceinline__ unsigned xb_ld(unsigned* p)              { return __hip_atomic_load(p, __ATOMIC_RELAXED, __HIP_MEMORY_SCOPE_AGENT); }
__device__ __forceinline__ unsigned xb_add(unsigned* p, unsigned v) { return __hip_atomic_fetch_add(p, v, __ATOMIC_RELAXED, __HIP_MEMORY_SCOPE_AGENT); }
__device__ __forceinline__ unsigned xb_xcc_id() { return (unsigned)__builtin_amdgcn_s_getreg((3 << 11) | 20) & 0xFu; }
#define XB_SPIN(cond, bar) do { unsigned _sp = 0; while (cond) { __builtin_amdgcn_s_sleep(1); \
    if ((++_sp & 255u) == 0u) { if (xb_ld(&(bar)[XB_TMO])) break; if (_sp > XB_SPIN_CAP) { atomicAdd(&(bar)[XB_TMO], 1u); break; } } } } while (0)
struct XcdBarrier { unsigned* bar; unsigned x; volatile LAS unsigned* st; };
__device__ __forceinline__ XcdBarrier xcd_barrier_post(unsigned* bar, volatile LAS unsigned* st) {
    XcdBarrier b; b.bar = bar; b.x = xb_xcc_id(); b.st = st;
    if (threadIdx.x == 0) (void)xb_add(&bar[XB_XCNT(b.x)], 1u);
    return b;
}
__device__ __forceinline__ void xcd_barrier_complete(unsigned* bar, unsigned x, unsigned& nloc, unsigned& nx) {
    const unsigned G = gridDim.x * gridDim.y * gridDim.z;
    unsigned sum, cnt, mine, sp = 0u;
    for (;;) {
        sum = 0u; cnt = 0u; mine = 0u;
#pragma unroll
        for (unsigned j = 0; j < 16; ++j) { const unsigned c = xb_ld(&bar[XB_XCNT(j)]); sum += c; cnt += (c > 0u) ? 1u : 0u; mine = (j == x) ? c : mine; }
        if (sum == G) break;
        __builtin_amdgcn_s_sleep(1);
        if ((++sp & 255u) == 0u) { if (xb_ld(&bar[XB_TMO])) break; if (sp > XB_SPIN_CAP) { atomicAdd(&bar[XB_TMO], 1u); break; } }
    }
    nloc = mine > 0u ? mine : 1u; nx = cnt > 0u ? cnt : 1u;
}
__device__ __forceinline__ void xcd_barrier(const XcdBarrier& b) {
    asm volatile("s_waitcnt vmcnt(0)" ::: "memory");
    __syncthreads();
    if (threadIdx.x == 0) {
        unsigned* bar = b.bar;
        __builtin_amdgcn_s_waitcnt(0);
        unsigned nloc = b.st[0], nx = b.st[1];
        if (nloc == 0u) { xcd_barrier_complete(bar, b.x, nloc, nx); b.st[0] = nloc; b.st[1] = nx; }
        const unsigned old = xb_add(&bar[XB_XSUB(b.x)], 1u);
        const unsigned gen = old / nloc;
        if (old + 1u == (gen + 1u) * nloc) {
            __builtin_amdgcn_fence(__ATOMIC_RELEASE, "agent");
            asm volatile("s_waitcnt vmcnt(0)" ::: "memory");
            const unsigned og = xb_add(&bar[XB_TOP], 1u);
            const unsigned tg = og / nx;
            if (og + 1u == (tg + 1u) * nx) xb_add(&bar[XB_TOPGEN], 1u);
            else XB_SPIN(xb_ld(&bar[XB_TOPGEN]) == tg, bar);
            __builtin_amdgcn_fence(__ATOMIC_ACQUIRE, "agent");
            xb_add(&bar[XB_XGEN(b.x)], 1u);
            asm volatile("s_waitcnt vmcnt(0)" ::: "memory");
        } else {
            XB_SPIN(xb_ld(&bar[XB_XGEN(b.x)]) == gen, bar);
            __builtin_amdgcn_fence(__ATOMIC_ACQUIRE, "agent");
            asm volatile("s_waitcnt vmcnt(0)" ::: "memory");
        }
    }
    __syncthreads();
}

#ifndef GEMM_ALIGN
#define GEMM_ALIGN true
#endif
#ifndef GEMM_SP2
#define GEMM_SP2 true
#endif
constexpr int N_PHASES = 1 + 6 * DEPTH;
__global__ void __launch_bounds__(512, 2) fwd_megakernel(Params p_unused) {
    extern __shared__ __attribute__((aligned(16))) unsigned char lds_raw[];
    LAS unsigned char* lds = (LAS unsigned char*)lds_raw;
    cg::grid_group grid = cg::this_grid();
    const int lo = kargs()->ph_lo, hi = kargs()->ph_hi;
    volatile LAS unsigned* bst = (volatile LAS unsigned*)(lds + LDS_BYTES - 64);
    if (threadIdx.x < 4) bst[threadIdx.x] = 0u;
    __syncthreads();
    XcdBarrier bar; bar.bar = (unsigned*)(kargs()->ws + WS_CTL); bar.x = xb_xcc_id(); bar.st = bst;
    if (threadIdx.x == 0) bst[3] = xb_add(&bar.bar[XB_XCNT(bar.x)], 1u);
#define IN(k) (lo <= (k) && (k) < hi)
#ifndef REP_MASK
#define REP_MASK 0u
#endif
#define REPS(i) for (int rep_ = 0; rep_ < (((REP_MASK >> (i)) & 1u) ? 2 : 1); ++rep_)
#define SEAM(k) do { if (IN(k) && IN((k) + 1)) xcd_barrier(bar); } while (0)
    if (lo < 0) grid.sync();
    if (IN(0)) REPS(0) { phase_p0(kargs(), lds); }
    SEAM(0);
    if (IN(0) && IN(1)) {
        if (threadIdx.x == 0) {
            bool even = (bst[1] == 8u) && (gridDim.x % 8u == 0u);
            for (unsigned j = 0; j < 16; ++j) { const unsigned c = xb_ld(&bar.bar[XB_XCNT(j)]); if (c != 0u && c != gridDim.x / 8u) even = false; }
            bst[2] = even ? bst[3] * 8u + bar.x : blockIdx.x; }
        __syncthreads();
    } else if (threadIdx.x == 0) bst[2] = blockIdx.x;
    __syncthreads();
    const int vc = (int)bst[2];
    for (int l = 0; l < DEPTH; ++l) {
        const int pb = 1 + 6 * l; KP p = kargs(); unsigned char* ws = p->ws;
        if (IN(pb + 0)) REPS(1) {
            pg8::Gemm g{(const bf16_t*)(ws + WS_XB), (const bf16_t*)(ws + WS_WIN + l * SZ_WIN), SEQ, DIN, DM};
            pg8::StaticOrder S; S.init(SEQ, DIN - 256, gridDim.x, vc);
            pg8::EpiH E{(bf16_t*)(ws + WS_HM), (bf16_t*)(ws + WS_HG)};
            pg8::gemm_phase<GEMM_ALIGN, GEMM_SP2>(lds, g, S, E);
        }
        SEAM(pb + 0);
        if (IN(pb + 1)) REPS(2) phase_mixers(p, lds, l);
        SEAM(pb + 1);
        if (IN(pb + 2)) REPS(3) {
            pg8::Gemm g{(const bf16_t*)(ws + WS_MIX), (const bf16_t*)(ws + WS_WP) + (size_t)l * 4 * 256 * 256, 4 * SEQ, 256, 256};
            pg8::PoolOrder S{(int)gridDim.x, (int)blockIdx.x};
            pg8::EpiPool E{(const bf16_t*)(ws + WS_HM), (bf16_t*)(ws + WS_Y)};
            pg8::gemm_phase<GEMM_ALIGN, GEMM_SP2>(lds, g, S, E);
        }
        SEAM(pb + 2);
        if (IN(pb + 3)) REPS(4) {
            pg8::Gemm g{(const bf16_t*)(ws + WS_Y), (const bf16_t*)(ws + WS_WB) + (size_t)l * 4 * 2048 * 1024, 4 * SEQ, 4 * 2048, 1024};
            pg8::BrOrder S; S.so.init(SEQ, DM, gridDim.x, vc);
            pg8::EpiBr E{(const bf16_t*)(ws + WS_HG), (bf16_t*)(ws + WS_MG)};
            pg8::gemm_phase<GEMM_ALIGN, GEMM_SP2>(lds, g, S, E);
        }
        SEAM(pb + 3);
        if (IN(pb + 4)) for (int rep_ = 0; rep_ < ((((REP_MASK >> 5) & 1u) && l == 0) ? 2 : 1); ++rep_) {
            pg8::Gemm g{(const bf16_t*)(ws + WS_MG), (const bf16_t*)(ws + WS_WO) + (size_t)l * 2048 * 2048, SEQ, DM, DM};
            pg8::StaticOrder S; S.init(SEQ, DM, gridDim.x, vc);
            pg8::EpiOut E{l == 0 ? p->in[0] : (const float*)p->out, p->out};
            pg8::gemm_phase<GEMM_ALIGN, GEMM_SP2>(lds, g, S, E);
        }
        SEAM(pb + 4);
        if (IN(pb + 5)) phase_ln(p, l);
        if (l + 1 < DEPTH) SEAM(pb + 5);
    }
#undef IN
#undef SEAM
}

extern "C" void kernel_launch(void* const* d_in, const int* in_sizes, int n_in, void* d_out, int out_size, void* d_ws, size_t ws_size, hipStream_t stream) {
    static int grid = 0;
    if (grid == 0) {
        if (n_in != 18 || out_size != SEQ * DM || ws_size < WS_END + CTL_BYTES) { fprintf(stderr, "kernel_launch: unexpected shapes (n_in %d out %d ws %zu need %zu)\n", n_in, out_size, ws_size, (size_t)WS_END); grid = -1; return; }
        int dev = 0, cus = 0, per_cu = 0;
        hipGetDevice(&dev);
        hipDeviceGetAttribute(&cus, hipDeviceAttributeMultiprocessorCount, dev);
        hipFuncSetAttribute((const void*)fwd_megakernel, hipFuncAttributeMaxDynamicSharedMemorySize, LDS_BYTES);
        hipOccupancyMaxActiveBlocksPerMultiprocessor(&per_cu, (const void*)fwd_megakernel, 512, LDS_BYTES);
        if (per_cu < 1) { fprintf(stderr, "kernel_launch: occupancy query says %d blocks per CU\n", per_cu); per_cu = 1; }
        grid = cus * per_cu;
        (void)hipGetLastError();
    }
    if (grid < 0) return;
    Params p{};
    for (int i = 0; i < 18; ++i) p.in[i] = (const float*)d_in[i];
    p.out = (float*)d_out; p.ws = (unsigned char*)d_ws;
#if N_LAUNCH_MODE == 1
    p.ph_lo = 0; p.ph_hi = N_PHASES;
    if (hipMemsetAsync((char*)d_ws + WS_CTL, 0, CTL_BYTES, stream) != hipSuccess) { fprintf(stderr, "kernel_launch: memset of barrier words failed\n"); return; }
    void* args[] = {&p};
    hipError_t e = hipLaunchCooperativeKernel((const void*)fwd_megakernel, dim3(grid), dim3(512), args, LDS_BYTES, stream);
    if (e != hipSuccess) fprintf(stderr, "cooperative launch failed: %s (grid %d)\n", hipGetErrorString(e), grid);
#else
    for (int ph = 0; ph < N_PHASES; ++ph) {
        p.ph_lo = ph; p.ph_hi = ph + 1;
        hipLaunchKernelGGL(fwd_megakernel, dim3(grid), dim3(512), LDS_BYTES, stream, p);
    }
#endif
}
```

```cpp
#include <hip/hip_runtime.h>
#include <hip/hip_cooperative_groups.h>
#include <cstdio>
namespace cg = cooperative_groups;

#define LAS __attribute__((address_space(3)))
typedef unsigned short bf16_t;
typedef short bf16x8 __attribute__((ext_vector_type(8)));
typedef float f32x4 __attribute__((ext_vector_type(4)));
typedef float f32x2 __attribute__((ext_vector_type(2)));
typedef unsigned u32x4 __attribute__((ext_vector_type(4)));
typedef unsigned u32x2 __attribute__((ext_vector_type(2)));

#ifndef N_LAUNCH_MODE
#define N_LAUNCH_MODE 1
#endif

constexpr int SEQ = 16384, DM = 2048, DIN = 18688, NMIX = 10496  , HMW = 8448  , HGW = 8192, DEPTH = 2;
constexpr int C_AIN = 0, C_AGATE = 1024, C_UG = 2048, C_V = 3072, C_Q = 4096, C_K = 5120, C_VV = 5248, C_CGATE = 5376, C_GLU = 6400, C_DGATE = 7424;
constexpr float LN_EPS = 1e-5f;
constexpr float ALPHA = 1.4142135623730951f;

constexpr size_t SZ_WIN = (size_t)DIN * DM * 2;
constexpr size_t WS_WIN = 0;
constexpr size_t WS_WB = WS_WIN + 2 * SZ_WIN;
constexpr size_t WS_WO = WS_WB + (size_t)2 * 4 * 2048 * 1024 * 2;
constexpr size_t WS_WP = WS_WO + (size_t)2 * 2048 * 2048 * 2;
constexpr size_t WS_XB = WS_WP + (size_t)2 * 4 * 256 * 256 * 2;
constexpr size_t WS_HM = WS_XB + (size_t)SEQ * DM * 2;
constexpr size_t WS_HG = WS_HM + (size_t)SEQ * HMW * 2;
constexpr size_t WS_Y = WS_HG + (size_t)SEQ * HGW * 2;
constexpr size_t WS_MIX = WS_Y + (size_t)4 * SEQ * 1024 * 2;
constexpr size_t WS_END = WS_MIX + (size_t)4 * SEQ * 256 * 2;
constexpr size_t WS_CTL = WS_END, CTL_BYTES = 16384;
constexpr size_t WS_MACC = WS_HM;
constexpr size_t WS_MG = WS_HM + (size_t)SEQ * DM * 4;
static_assert(WS_MG + (size_t)SEQ * DM * 2 <= WS_HG, "alias map");

constexpr int LDS_BYTES = 147456;

struct Params {
    const float* in[18];
    float* out;
    unsigned char* ws;
    int ph_lo, ph_hi;
};

typedef const __attribute__((address_space(4))) Params* KP;
__device__ __forceinline__ KP kargs() { KP q = (KP)__builtin_amdgcn_kernarg_segment_ptr(); asm volatile("" : "+s"(q)); return q; }
#define OPAQUE_V(x) asm volatile("" : "+v"(x))
#define OPAQUE_S(x) asm volatile("" : "+s"(x))

__device__ __forceinline__ float bflo(unsigned w) { return __uint_as_float(w << 16); }
__device__ __forceinline__ float bfhi(unsigned w) { return __uint_as_float(w & 0xffff0000u); }
typedef __bf16 bf16v2_t __attribute__((ext_vector_type(2)));
__device__ __forceinline__ unsigned pk2(float lo, float hi) { bf16v2_t v; v[0] = (__bf16)lo; v[1] = (__bf16)hi; return __builtin_bit_cast(unsigned, v); }
__device__ __forceinline__ float sigmoidf_(float x) { return __builtin_amdgcn_rcpf(1.0f + __expf(-x)); }
__device__ __forceinline__ float siluf_(float x) { return x * sigmoidf_(x); }
__device__ __forceinline__ float wave_sum(float v) {
#pragma unroll
    for (int o = 1; o < 64; o <<= 1) v += __shfl_xor(v, o);
    return v;
}
__device__ __forceinline__ f32x4 mfma16(bf16x8 a, bf16x8 b, f32x4 c) { return __builtin_amdgcn_mfma_f32_16x16x32_bf16(a, b, c, 0, 0, 0); }

__constant__ unsigned char T5_BUCKET[128] = {0, 1, 2, 3, 4, 5, 6, 7, 8, 9, 10, 11, 12, 13, 14, 15, 16, 16, 16, 17, 17, 18, 18, 18, 19, 19, 19, 20, 20, 20, 20, 21, 21, 21, 21, 22, 22, 22, 22, 22, 23, 23, 23, 23, 23, 23, 24, 24, 24, 24, 24, 24, 25, 25, 25, 25, 25, 25, 25, 26, 26, 26, 26, 26, 26, 26, 26, 27, 27, 27, 27, 27, 27, 27, 27, 27, 27, 28, 28, 28, 28, 28, 28, 28, 28, 28, 28, 29, 29, 29, 29, 29, 29, 29, 29, 29, 29, 29, 29, 30, 30, 30, 30, 30, 30, 30, 30, 30, 30, 30, 30, 30, 30, 31, 31, 31, 31, 31, 31, 31, 31, 31, 31, 31, 31, 31, 31, 31};

namespace pg8 {
constexpr int BM = 256, BK = 64, HALF = 128, HTB = HALF * BK * 2, STAGE_BYTES = 8 * HTB, NXCD = 8, WGM = 3;
__device__ __forceinline__ int lds_byte(int r, int c) { const int st = (r >> 4) * 2 + (c >> 5), rr = r & 15, cc = c & 31, ob = rr * 64 + cc * 2; return st * 1024 + (ob ^ (((ob >> 9) & 1) << 5)); }
__device__ __forceinline__ void stage_rc(int b, int& R, int& C) { const int st = b / 1024, sb = b % 1024, swz = sb ^ (((sb >> 9) & 1) << 5); R = (st >> 1) * 16 + swz / 64; C = (st & 1) * 32 + (swz % 64) / 2; }
__device__ __forceinline__ int perm32(int rho) { const int n = rho >> 4, i = rho & 15; return 8 * (i >> 2) + 4 * n + (i & 3); }

struct Unit { int pm, pn; };
struct Gemm { const bf16_t* A; const bf16_t* Bt; int M, N, K; };

struct StaticOrder {
    int nM, nN, nwg, G, c, limit;
    __device__ void init(int M, int N, int G_, int c_) { nM = M / BM; nN = N / BM; nwg = nM * nN; G = G_; c = c_; limit = nwg; }
    __device__ bool next(int i, Unit& u) const {
        const long L = (long)i * G + c; if (L >= limit) return false;
        int wgid = (int)L; { const int q = nwg / NXCD, r = nwg % NXCD, xcd = wgid % NXCD, off = wgid / NXCD; wgid = (xcd < r ? xcd * (q + 1) : r * (q + 1) + (xcd - r) * q) + off; }
        const int nig = WGM * nN, gid = wgid / nig, fm = gid * WGM, gsz = (nM - fm) < WGM ? (nM - fm) : WGM;
        u.pm = fm + ((wgid % nig) % gsz); u.pn = (wgid % nig) / gsz; return true;
    }
};
struct ExtraOrder {
    int pm, pn;
    __device__ bool next(int i, Unit& u) const { if (i != 0) return false; u.pm = pm; u.pn = pn; return true; }
};
struct PoolOrder {
    int G, c;
    __device__ bool next(int i, Unit& u) const { const int L = i * G + c; if (L >= 256) return false; u.pm = L; u.pn = L >> 6; return true; }
};
struct BrOrder {
    StaticOrder so;
    __device__ bool next(int i, Unit& u) const { Unit t; if (!so.next(i >> 2, t)) return false; const int b = i & 3; u.pm = b * 64 + t.pm; u.pn = b * 8 + t.pn; return true; }
};

template <bool ALIGN_EPI, bool SP2, class Epi, class Sched>
__device__ __forceinline__ void gemm_phase(LAS unsigned char* lds, const Gemm g, const Sched& S, const Epi& E) {
    int tid_ = threadIdx.x; OPAQUE_V(tid_); int K_ = g.K; OPAQUE_S(K_);
    const int tid = tid_, wid = __builtin_amdgcn_readfirstlane(tid >> 6), lane = tid & 63, wr = wid >> 2, wc = wid & 3, fr = lane & 15, fq = lane >> 4;
    const int K = K_, nt = K / BK;
    unsigned voffA[2], voffB[2];
#pragma unroll
    for (int i = 0; i < 2; ++i) { int R, C; stage_rc(tid * 16 + i * 8192, R, C); const int Rb = Epi::PERM ? ((R & ~31) + perm32(R & 31)) : R;
        voffA[i] = (unsigned)(R * K + C) * 2u; voffB[i] = (unsigned)(Rb * K + C) * 2u; }
    const size_t kstep = (size_t)(BK * 2);
    const size_t hstep = (size_t)HALF * K * 2;
    const size_t tstep = 2 * hstep;
    const unsigned ldsw = (unsigned)wid * 1024u;
    const int aoff = lds_byte(wr * 64 + fr, fq * 8), boff = lds_byte(wc * 32 + fr, fq * 8);
#define PG8_SA(b, h) (((b) * 2 + (h)) * HTB)
#define PG8_SB(b, h) ((4 + (b) * 2 + (h)) * HTB)
#define PG8_STAGE(bufoff, gbase, voff) do { _Pragma("unroll") for (int _i = 0; _i < 2; ++_i) \
        __builtin_amdgcn_global_load_lds((const unsigned*)((const char*)(gbase) + (voff)[_i]), (LAS unsigned*)(lds + (bufoff) + ldsw + _i * 8192), 16, 0, 0); } while (0)
#define PG8_LDA(dst, b, h) do { _Pragma("unroll") for (int m = 0; m < 4; ++m) _Pragma("unroll") for (int k = 0; k < 2; ++k) dst[m][k] = *(const LAS bf16x8*)(lds + PG8_SA(b, h) + aoff + m * 2048 + k * 1024); } while (0)
#define PG8_LDB(dst, b, h) do { _Pragma("unroll") for (int n = 0; n < 2; ++n) _Pragma("unroll") for (int k = 0; k < 2; ++k) dst[n][k] = *(const LAS bf16x8*)(lds + PG8_SB(b, h) + boff + n * 2048 + k * 1024); } while (0)
#define PG8_MMA(ai, bj, At, Bt) do { __builtin_amdgcn_s_setprio(1); _Pragma("unroll") for (int m = 0; m < 4; ++m) _Pragma("unroll") for (int n = 0; n < 2; ++n) _Pragma("unroll") for (int k = 0; k < 2; ++k) \
        acc[ai][bj][m][n] = __builtin_amdgcn_mfma_f32_16x16x32_bf16(Bt[n][k], At[m][k], acc[ai][bj][m][n], 0, 0, 0); __builtin_amdgcn_s_setprio(0); } while (0)
#define PG8_WAIT_V(n) asm volatile("s_waitcnt vmcnt(" #n ")" ::: "memory")
#define PG8_WAIT_L(n) asm volatile("s_waitcnt lgkmcnt(" #n ")" ::: "memory")
#define PG8_BAR __builtin_amdgcn_s_barrier()
#define PG8_SCHED __builtin_amdgcn_sched_barrier(0)
    Unit cur, nxt; int ui = 0;
    if (!S.next(0, cur)) return;
    f32x4 acc[2][2][4][2];
#pragma unroll
    for (int a = 0; a < 2; ++a)
#pragma unroll
        for (int b = 0; b < 2; ++b)
#pragma unroll
            for (int m = 0; m < 4; ++m)
#pragma unroll
                for (int n = 0; n < 2; ++n) acc[a][b][m][n] = (f32x4){0.f, 0.f, 0.f, 0.f};
    bf16x8 At[4][2], B0[2][2], B1[2][2];
    const char* cA = (const char*)g.A + (size_t)cur.pm * tstep; const char* cB = (const char*)g.Bt + (size_t)cur.pn * tstep;
    if constexpr (SP2) {
        PG8_STAGE(PG8_SB(0, 0), cB, voffB); PG8_STAGE(PG8_SB(0, 1), cB + hstep, voffB); PG8_STAGE(PG8_SA(0, 0), cA, voffA); PG8_STAGE(PG8_SA(0, 1), cA + hstep, voffA);
        if (wr == 1) PG8_BAR;
        PG8_WAIT_V(2); PG8_BAR;
        PG8_STAGE(PG8_SB(1, 0), cB + kstep, voffB); PG8_STAGE(PG8_SA(1, 0), cA + kstep, voffA); PG8_STAGE(PG8_SB(1, 1), cB + hstep + kstep, voffB);
        PG8_WAIT_V(6); PG8_BAR;
    } else {
        PG8_STAGE(PG8_SB(0, 0), cB, voffB); PG8_STAGE(PG8_SA(0, 0), cA, voffA); PG8_STAGE(PG8_SB(0, 1), cB + hstep, voffB); PG8_STAGE(PG8_SA(0, 1), cA + hstep, voffA);
        if (wr == 1) PG8_BAR;
        PG8_WAIT_V(4); PG8_BAR;
        PG8_STAGE(PG8_SB(1, 0), cB + kstep, voffB); PG8_STAGE(PG8_SA(1, 0), cA + kstep, voffA); PG8_STAGE(PG8_SB(1, 1), cB + hstep + kstep, voffB);
        PG8_WAIT_V(6); PG8_BAR;
    }
    for (;;) {
        const bool has_next = S.next(ui + 1, nxt);
        const char* nA = has_next ? (const char*)g.A + (size_t)nxt.pm * tstep : cA; const char* nB = has_next ? (const char*)g.Bt + (size_t)nxt.pn * tstep : cB;
        for (int t = 0; t < nt; t += 2) {
            const bool last = (t == nt - 2);
            const char* a1 = cA + (size_t)(t + 1) * kstep;
            const char* a2 = last ? nA : cA + (size_t)(t + 2) * kstep; const char* b2 = last ? nB : cB + (size_t)(t + 2) * kstep;
            const char* a3 = a2 + kstep; const char* b3 = b2 + kstep;
            if constexpr (SP2) {
            PG8_LDB(B0, 0, 0); PG8_LDB(B1, 0, 1); PG8_SCHED; PG8_LDA(At, 0, 0); PG8_STAGE(PG8_SA(1, 1), a1 + hstep, voffA);
            PG8_WAIT_V(8); PG8_WAIT_L(0); PG8_BAR; PG8_MMA(0, 0, At, B0); PG8_MMA(0, 1, At, B1); PG8_BAR; PG8_SCHED;
            PG8_LDA(At, 0, 1); PG8_STAGE(PG8_SB(0, 0), b2, voffB); PG8_STAGE(PG8_SB(0, 1), b2 + hstep, voffB); PG8_STAGE(PG8_SA(0, 0), a2, voffA);
            PG8_WAIT_V(8); PG8_WAIT_L(0); PG8_BAR; PG8_MMA(1, 0, At, B0); PG8_MMA(1, 1, At, B1); PG8_BAR; PG8_SCHED;
            PG8_LDB(B0, 1, 0); PG8_LDB(B1, 1, 1); PG8_SCHED; PG8_LDA(At, 1, 0); PG8_STAGE(PG8_SA(0, 1), a2 + hstep, voffA);
            PG8_WAIT_V(8); PG8_WAIT_L(0); PG8_BAR; PG8_MMA(0, 0, At, B0); PG8_MMA(0, 1, At, B1); PG8_BAR; PG8_SCHED;
            PG8_LDA(At, 1, 1); PG8_STAGE(PG8_SB(1, 0), b3, voffB); PG8_STAGE(PG8_SB(1, 1), b3 + hstep, voffB); PG8_STAGE(PG8_SA(1, 0), a3, voffA);
            PG8_WAIT_V(8); PG8_WAIT_L(0); PG8_BAR; PG8_MMA(1, 0, At, B0); PG8_MMA(1, 1, At, B1); PG8_BAR; PG8_SCHED;
            } else {
            PG8_LDB(B0, 0, 0); PG8_SCHED; PG8_LDA(At, 0, 0); PG8_STAGE(PG8_SA(1, 1), a1 + hstep, voffA);
            PG8_WAIT_L(8); PG8_BAR; PG8_WAIT_L(0); PG8_MMA(0, 0, At, B0); PG8_BAR; PG8_SCHED;
            PG8_LDB(B1, 0, 1); PG8_STAGE(PG8_SB(0, 0), b2, voffB);
            PG8_BAR; PG8_WAIT_L(0); PG8_MMA(0, 1, At, B1); PG8_BAR;
            PG8_LDA(At, 0, 1); PG8_STAGE(PG8_SA(0, 0), a2, voffA);
            PG8_BAR; PG8_WAIT_L(0); PG8_MMA(1, 0, At, B0); PG8_BAR; PG8_SCHED;
            PG8_STAGE(PG8_SB(0, 1), b2 + hstep, voffB);
            PG8_WAIT_V(6); PG8_BAR; PG8_MMA(1, 1, At, B1); PG8_BAR;
            PG8_LDB(B0, 1, 0); PG8_SCHED; PG8_LDA(At, 1, 0); PG8_STAGE(PG8_SA(0, 1), a2 + hstep, voffA);
            PG8_WAIT_L(8); PG8_BAR; PG8_WAIT_L(0); PG8_MMA(0, 0, At, B0); PG8_BAR; PG8_SCHED;
            PG8_LDB(B1, 1, 1); PG8_STAGE(PG8_SB(1, 0), b3, voffB);
            PG8_BAR; PG8_WAIT_L(0); PG8_MMA(0, 1, At, B1); PG8_BAR;
            PG8_LDA(At, 1, 1); PG8_STAGE(PG8_SA(1, 0), a3, voffA);
            PG8_BAR; PG8_WAIT_L(0); PG8_MMA(1, 0, At, B0); PG8_BAR; PG8_SCHED;
            PG8_STAGE(PG8_SB(1, 1), b3 + hstep, voffB);
            PG8_WAIT_V(6); PG8_BAR; PG8_MMA(1, 1, At, B1); PG8_BAR;
            }
        }
        if constexpr (ALIGN_EPI) { if (wr == 0) PG8_BAR; }
        E(acc, cur, wr, wc, fr, fq);
        if (!has_next) break;
        if (E.zero_after(cur))
#pragma unroll
        for (int a = 0; a < 2; ++a)
#pragma unroll
            for (int b = 0; b < 2; ++b)
#pragma unroll
                for (int m = 0; m < 4; ++m)
#pragma unroll
                    for (int n = 0; n < 2; ++n) acc[a][b][m][n] = (f32x4){0.f, 0.f, 0.f, 0.f};
        cur = nxt; cA = nA; cB = nB; ++ui;
        if constexpr (ALIGN_EPI) { if (wr == 1) PG8_BAR; }
    }
    PG8_WAIT_V(0);
    if constexpr (!ALIGN_EPI) { if (wr == 0) PG8_BAR; }
    PG8_BAR;
#undef PG8_SA
#undef PG8_SB
#undef PG8_STAGE
#undef PG8_LDA
#undef PG8_LDB
#undef PG8_MMA
#undef PG8_WAIT_V
#undef PG8_WAIT_L
#undef PG8_BAR
#undef PG8_SCHED
}

struct EpiH {
    static constexpr bool PERM = true, PROBE2X = true;
    bf16_t* HM; bf16_t* HG;
    __device__ __forceinline__ bool zero_after(const Unit&) const { return true; }
    __device__ __forceinline__ void operator()(f32x4 (&acc)[2][2][4][2], const Unit& u, int wr, int wc, int fr, int fq) const {
        const int pn = u.pn;
        int act = 0; float scale = 1.f; int colt;
        if (pn < 8) { colt = pn * 256; if (pn >= 4) act = 1; }
        else if (pn < 16) { colt = C_UG + (pn - 8) * 128; act = 3; }
        else if (pn < 20) colt = C_V + (pn - 16) * 256;
        else if (pn < 24) { colt = C_Q + (pn - 20) * 256; scale = 0.125f; }
        else if (pn < 25) colt = C_K;
        else if (pn < 29) { colt = C_CGATE + (pn - 25) * 256; act = 1; }
        else if (pn < 37) { colt = C_GLU + (pn - 29) * 128; act = 4; }
        else { colt = C_DGATE + (pn - 37) * 256; act = 1; }
        if (pn >= 41) {
            const int row0 = u.pm * BM + wr * 64 + fr, d0 = (pn - 41) * 64 + wc * 16 + 4 * fq;
#pragma unroll
            for (int ai = 0; ai < 2; ++ai)
#pragma unroll
                for (int m = 0; m < 4; ++m) { bf16_t* rowp = HG + (size_t)(row0 + ai * HALF + m * 16) * HGW + d0;
                    u32x2 w[4];
#pragma unroll
                    for (int jp = 0; jp < 2; ++jp) { float r[2][4];
#pragma unroll
                        for (int jj = 0; jj < 2; ++jj) { const int j = 2 * jp + jj; float e[4];
#pragma unroll
                            for (int i = 0; i < 4; ++i) e[i] = 1.0f + __expf(-fminf(fmaxf(acc[ai][i >> 1][m][i & 1][j], -30.f), 30.f));
                            r[jj][0] = e[1] * __builtin_amdgcn_rcpf(e[0]); r[jj][1] = e[2] * __builtin_amdgcn_rcpf(e[1]); r[jj][2] = e[3] * __builtin_amdgcn_rcpf(e[2]); r[jj][3] = __builtin_amdgcn_rcpf(e[3]); }
#pragma unroll
                        for (int k = 0; k < 4; ++k) { const unsigned pk = pk2(r[0][k], r[1][k]); if (jp == 0) w[k].x = pk; else w[k].y = pk; } }
#pragma unroll
                    for (int k = 0; k < 4; ++k) *(u32x2*)(rowp + k * 2048) = w[k];
                    asm volatile("" ::: "memory"); }
            return;
        }
        bf16_t* base = HM; const int ldc = HMW;
        if (act >= 3) {
            const int row0 = u.pm * BM + wr * 64 + fr, col0 = colt + wc * 32 + 8 * fq;
#pragma unroll
            for (int ai = 0; ai < 2; ++ai)
#pragma unroll
                for (int m = 0; m < 4; ++m) { bf16_t* rowp = base + (size_t)(row0 + ai * HALF + m * 16) * ldc + col0;
                    f32x4 v0 = acc[ai][0][m][0], v1 = acc[ai][0][m][1]; const f32x4 g0 = acc[ai][1][m][0], g1 = acc[ai][1][m][1];
#pragma unroll
                    for (int j = 0; j < 4; ++j) { const float s0 = sigmoidf_(g0[j]), s1 = sigmoidf_(g1[j]);
                        v0[j] *= (act == 3) ? g0[j] * s0 : s0; v1[j] *= (act == 3) ? g1[j] * s1 : s1; }
                    u32x4 w; w.x = pk2(v0[0], v0[1]); w.y = pk2(v0[2], v0[3]); w.z = pk2(v1[0], v1[1]); w.w = pk2(v1[2], v1[3]);
                    *(u32x4*)rowp = w; }
            return;
        }
        const int row0 = u.pm * BM + wr * 64 + fr, col0 = colt + wc * 32 + 8 * fq;
#pragma unroll
        for (int ai = 0; ai < 2; ++ai)
#pragma unroll
            for (int m = 0; m < 4; ++m) { bf16_t* rowp = base + (size_t)(row0 + ai * HALF + m * 16) * ldc + col0;
#pragma unroll
                for (int bj = 0; bj < 2; ++bj) { f32x4 v0 = acc[ai][bj][m][0] * scale, v1 = acc[ai][bj][m][1] * scale;
                    if (act == 1) {
#pragma unroll
                        for (int j = 0; j < 4; ++j) { v0[j] = siluf_(v0[j]); v1[j] = siluf_(v1[j]); } }
                    u32x4 w; w.x = pk2(v0[0], v0[1]); w.y = pk2(v0[2], v0[3]); w.z = pk2(v1[0], v1[1]); w.w = pk2(v1[2], v1[3]);
                    *(u32x4*)(rowp + bj * HALF) = w; } }
    }
};
struct EpiPool {
    static constexpr bool PERM = true, PROBE2X = false;
    const bf16_t* HM; bf16_t* YA;
    __device__ __forceinline__ bool zero_after(const Unit&) const { return true; }
    __device__ __forceinline__ void operator()(f32x4 (&acc)[2][2][4][2], const Unit& u, int wr, int wc, int fr, int fq) const {
        const int g = u.pm >> 6; const int row0 = (u.pm & 63) * BM + wr * 64 + fr, col0 = g * 256 + wc * 32 + 8 * fq;
#pragma unroll
        for (int ai = 0; ai < 2; ++ai)
#pragma unroll
            for (int m = 0; m < 4; ++m) { const size_t row = (size_t)(row0 + ai * HALF + m * 16);
#pragma unroll
                for (int bj = 0; bj < 2; ++bj) { const int col = col0 + bj * HALF;
                    const u32x4 gt = *(const u32x4*)(HM + row * HMW + C_AGATE + col);
                    const f32x4 v0 = acc[ai][bj][m][0], v1 = acc[ai][bj][m][1];
                    u32x4 w; w.x = pk2(v0[0] * bflo(gt.x), v0[1] * bfhi(gt.x)); w.y = pk2(v0[2] * bflo(gt.y), v0[3] * bfhi(gt.y));
                    w.z = pk2(v1[0] * bflo(gt.z), v1[1] * bfhi(gt.z)); w.w = pk2(v1[2] * bflo(gt.w), v1[3] * bfhi(gt.w));
                    *(u32x4*)(YA + row * 1024 + col) = w; } }
    }
};
struct EpiBr {
    static constexpr bool PERM = true, PROBE2X = false;
    const bf16_t* HG; bf16_t* MG;
    __device__ __forceinline__ bool zero_after(const Unit& u) const { return (u.pm >> 6) == 3; }
    __device__ __forceinline__ void operator()(f32x4 (&acc)[2][2][4][2], const Unit& u, int wr, int wc, int fr, int fq) const {
        const int br = u.pm >> 6; const int row0 = (u.pm & 63) * BM + wr * 64 + fr, col0 = (u.pn & 7) * BM + wc * 32 + 8 * fq;
#pragma unroll
        for (int ai = 0; ai < 2; ++ai)
#pragma unroll
            for (int m = 0; m < 4; ++m) { const size_t row = (size_t)(row0 + ai * HALF + m * 16);
#pragma unroll
                for (int bj = 0; bj < 2; ++bj) { const int col = col0 + bj * HALF;
                    const u32x4 gt = *(const u32x4*)(HG + row * HGW + br * 2048 + col);
                    f32x4 v0 = acc[ai][bj][m][0], v1 = acc[ai][bj][m][1];
                    v0[0] *= bflo(gt.x); v0[1] *= bfhi(gt.x); v0[2] *= bflo(gt.y); v0[3] *= bfhi(gt.y);
                    v1[0] *= bflo(gt.z); v1[1] *= bfhi(gt.z); v1[2] *= bflo(gt.w); v1[3] *= bfhi(gt.w);
                    if (br < 3) { acc[ai][bj][m][0] = v0; acc[ai][bj][m][1] = v1; }
                    else { u32x4 w; w.x = pk2(v0[0], v0[1]); w.y = pk2(v0[2], v0[3]); w.z = pk2(v1[0], v1[1]); w.w = pk2(v1[2], v1[3]); *(u32x4*)(MG + row * DM + col) = w; } } }
    }
};
struct EpiOut {
    static constexpr bool PERM = false, PROBE2X = false;
    const float* xres; float* out;
    __device__ __forceinline__ bool zero_after(const Unit&) const { return true; }
    __device__ __forceinline__ void operator()(f32x4 (&acc)[2][2][4][2], const Unit& u, int wr, int wc, int fr, int fq) const {
        const int row0 = u.pm * BM + wr * 64 + fr, col0 = u.pn * BM + wc * 32 + 4 * fq;
#pragma unroll
        for (int ai = 0; ai < 2; ++ai)
#pragma unroll
            for (int m = 0; m < 4; ++m) { const size_t ro = (size_t)(row0 + ai * HALF + m * 16) * DM + col0;
#pragma unroll
                for (int bj = 0; bj < 2; ++bj)
#pragma unroll
                    for (int n = 0; n < 2; ++n) { const f32x4 xr = *(const f32x4*)(xres + ro + bj * HALF + n * 16);
                        *(f32x4*)(out + ro + bj * HALF + n * 16) = xr * ALPHA + acc[ai][bj][m][n]; } }
    }
};
}

__device__ __forceinline__ void p0_transpose_item(const float* W, int K, int N, bf16_t* WT, LAS float* scr, int item, int lane, const float* nscale = nullptr, bool gate_remap = false) {
    const int nblk = N / 32, kb = item / nblk, nb = item % nblk, k0 = 64 * kb, n0 = 32 * nb;
#pragma unroll 8
    for (int i = 0; i < 32; ++i) { const int kk = 2 * i + (lane >> 5); scr[kk * 33 + (lane & 31)] = W[(size_t)(k0 + kk) * N + n0 + (lane & 31)]; }
    asm volatile("s_waitcnt lgkmcnt(0)" ::: "memory");
    const int c = lane & 7;
#pragma unroll
    for (int j = 0; j < 4; ++j) { const int n = (lane >> 3) + 8 * j; const LAS float* s = scr + (8 * c) * 33 + n;
        const float sc = nscale ? nscale[n0 + n] : 1.0f;
        u32x4 o; o.x = pk2(s[0 * 33] * sc, s[1 * 33] * sc); o.y = pk2(s[2 * 33] * sc, s[3 * 33] * sc); o.z = pk2(s[4 * 33] * sc, s[5 * 33] * sc); o.w = pk2(s[6 * 33] * sc, s[7 * 33] * sc);
        int orow = n0 + n;
        if (gate_remap) {
            const int n_ = orow;
            if (n_ >= NMIX) { const int g = n_ - NMIX, i = g >> 11, d = g & 2047, dl = d & 63;
                orow = NMIX + (d >> 6) * 256 + 128 * (i >> 1) + 32 * (dl >> 4) + 8 * ((dl >> 2) & 3) + 4 * (i & 1) + (dl & 3); }
            else if (n_ >= 2048 && n_ < 3072) { const int ch = n_ - 2048; orow = (8 + (ch >> 7)) * 256 + (ch & 127); }
            else if (n_ >= 3072 && n_ < 4096) orow = 16 * 256 + (n_ - 3072);
            else if (n_ >= 4096 && n_ < 5120) { const int ch = n_ - 4096; orow = (8 + (ch >> 7)) * 256 + 128 + (ch & 127); }
            else if (n_ >= 7424 && n_ < 8448) { const int ch = n_ - 7424; orow = (29 + (ch >> 7)) * 256 + (ch & 127); }
            else if (n_ >= 8448 && n_ < 9472) { const int ch = n_ - 8448; orow = (29 + (ch >> 7)) * 256 + 128 + (ch & 127); } }
        *(u32x4*)(WT + (size_t)orow * K + k0 + 8 * c) = o; }
    asm volatile("s_waitcnt lgkmcnt(0)" ::: "memory");
}
__device__ __forceinline__ void phase_p0(KP p, LAS unsigned char* lds) {
    int tid_ = threadIdx.x; OPAQUE_V(tid_); const int tid = tid_, wid = tid >> 6, lane = tid & 63;
    LAS float* scr = (LAS float*)(lds + wid * 16384);
    const int gw = blockIdx.x * 8 + wid, NGW = gridDim.x * 8;
    constexpr int I_IN = 32 * 584, I_BR = 16 * 64, I_OUT = 32 * 64, I_PW = 4 * 8, PER_L = I_IN + 4 * I_BR + I_OUT + 4 * I_PW;
    for (int it = gw; it < 2 * PER_L; it += NGW) {
        const int l = it / PER_L; int r = it % PER_L;
        if (r < I_IN) { p0_transpose_item(p->in[1] + (size_t)l * DM * DIN, DM, DIN, (bf16_t*)(p->ws + WS_WIN + l * SZ_WIN), scr, r, lane, nullptr, true); continue; } r -= I_IN;
        if (r < 4 * I_BR) { const int i = r / I_BR; p0_transpose_item(p->in[14] + (size_t)(l * 4 + i) * 1024 * 2048, 1024, 2048, (bf16_t*)(p->ws + WS_WB) + (size_t)(l * 4 + i) * 2048 * 1024, scr, r % I_BR, lane); continue; } r -= 4 * I_BR;
        if (r < I_OUT) { p0_transpose_item(p->in[15] + (size_t)l * 2048 * 2048, 2048, 2048, (bf16_t*)(p->ws + WS_WO) + (size_t)l * 2048 * 2048, scr, r, lane); continue; } r -= I_OUT;
        { const int g = r / I_PW; p0_transpose_item(p->in[2] + (size_t)(l * 4 + g) * 256 * 256, 256, 256, (bf16_t*)(p->ws + WS_WP) + (size_t)(l * 4 + g) * 256 * 256, scr, r % I_PW, lane, p->in[3] + l * 1024 + g * 256); }
    }
    const float* x = p->in[0]; bf16_t* xb = (bf16_t*)(p->ws + WS_XB);
    const size_t n8 = (size_t)SEQ * DM / 8;
    for (size_t i = (size_t)blockIdx.x * 512 + tid; i < n8; i += (size_t)gridDim.x * 512) {
        const f32x4 a = *(const f32x4*)(x + i * 8), b = *(const f32x4*)(x + i * 8 + 4);
        u32x4 w; w.x = pk2(a[0], a[1]); w.y = pk2(a[2], a[3]); w.z = pk2(b[0], b[1]); w.w = pk2(b[2], b[3]);
        *(u32x4*)(xb + i * 8) = w;
    }
    __syncthreads();
}

__device__ __forceinline__ void attn_item(KP p, LAS unsigned char* lds, int l, int n, int hk) {
    int tid_ = threadIdx.x; OPAQUE_V(tid_);
    const int tid = tid_, wid = __builtin_amdgcn_readfirstlane(tid >> 6), lane = tid & 63, fr = lane & 15, fq = lane >> 4;
    const bf16_t* HM = (const bf16_t*)(p->ws + WS_HM);
    bf16_t* YC = (bf16_t*)(p->ws + WS_Y) + (size_t)2 * SEQ * 1024;
    LAS bf16_t* Ks = (LAS bf16_t*)lds;
    LAS unsigned* Vt32 = (LAS unsigned*)(lds + 36864);
    LAS float* bias = (LAS float*)(lds + 36864 + 35840);
    const int tokb = (n - 1) * 128;
    for (int idx = tid; idx < 2048; idx += 512) { const int key = idx >> 3, pc = idx & 7; const int tok = tokb + key;
        u32x4 v = (u32x4){0u, 0u, 0u, 0u}; if (tok >= 0) v = *(const u32x4*)(HM + (size_t)tok * HMW + C_K + hk * 64 + pc * 8);
        *(LAS u32x4*)(Ks + key * 72 + pc * 8) = v; }
    for (int idx = tid; idx < 1024; idx += 512) { const int p2 = idx & 127, dg = idx >> 7; const int tok0 = tokb + 2 * p2;
        u32x4 a = (u32x4){0u, 0u, 0u, 0u}, b = a;
        if (tok0 >= 0) { a = *(const u32x4*)(HM + (size_t)tok0 * HMW + C_VV + hk * 64 + dg * 8); b = *(const u32x4*)(HM + (size_t)(tok0 + 1) * HMW + C_VV + hk * 64 + dg * 8); }
        LAS unsigned* o = Vt32 + (dg * 8) * 140 + p2;
        o[0 * 140] = (a.x & 0xffffu) | (b.x << 16); o[1 * 140] = (a.x >> 16) | (b.x & 0xffff0000u);
        o[2 * 140] = (a.y & 0xffffu) | (b.y << 16); o[3 * 140] = (a.y >> 16) | (b.y & 0xffff0000u);
        o[4 * 140] = (a.z & 0xffffu) | (b.z << 16); o[5 * 140] = (a.z >> 16) | (b.z & 0xffff0000u);
        o[6 * 140] = (a.w & 0xffffu) | (b.w << 16); o[7 * 140] = (a.w >> 16) | (b.w & 0xffff0000u); }
    for (int idx = tid; idx < 768; idx += 512) Vt32[(idx / 12) * 140 + 128 + (idx % 12)] = 0u;
    for (int idx = tid; idx < 1024; idx += 512) { const int w = idx >> 7, d = idx & 127; bias[idx] = p->in[9][(int)T5_BUCKET[d] * 16 + hk * 8 + w]; }
    __syncthreads();
    const int h = hk * 8 + wid;
    const float sink = p->in[8][l * 16 + h];
    const LAS float* bh = bias + wid * 128;
    float bv[9][4];
#pragma unroll
    for (int k9 = 0; k9 < 9; ++k9)
#pragma unroll
        for (int j = 0; j < 4; ++j) { const int dist = 128 - 16 * k9 + fr - fq * 4 - j; bv[k9][j] = (dist >= 0 && dist < 128) ? bh[dist & 127] : -1e30f; }
    bf16x8 qnA0, qnA1, qnB0, qnB1;
    { const bf16_t* qrow = HM + (size_t)(n * 128 + fr) * HMW + C_Q + h * 64 + fq * 8; qnA0 = *(const bf16x8*)qrow; qnA1 = *(const bf16x8*)(qrow + 32);
      qnB0 = *(const bf16x8*)(qrow + (size_t)16 * HMW); qnB1 = *(const bf16x8*)(qrow + (size_t)16 * HMW + 32); }
#pragma unroll 1
    for (int t2 = 0; t2 < 4; ++t2) {
        const int qa = 2 * t2; const int tokA = n * 128 + qa * 16 + fr, tokB = tokA + 16;
        const bf16x8 qA0 = qnA0, qA1 = qnA1, qB0 = qnB0, qB1 = qnB1;
        { const int tn = n * 128 + (t2 < 3 ? qa + 2 : qa) * 16 + fr; const bf16_t* qrow = HM + (size_t)tn * HMW + C_Q + h * 64 + fq * 8;
          qnA0 = *(const bf16x8*)qrow; qnA1 = *(const bf16x8*)(qrow + 32); qnB0 = *(const bf16x8*)(qrow + (size_t)16 * HMW); qnB1 = *(const bf16x8*)(qrow + (size_t)16 * HMW + 32); }
        u32x2 cgA[4], cgB[4];
#pragma unroll
        for (int dt = 0; dt < 4; ++dt) { cgA[dt] = *(const u32x2*)(HM + (size_t)tokA * HMW + C_CGATE + h * 64 + dt * 16 + fq * 4); cgB[dt] = *(const u32x2*)(HM + (size_t)tokB * HMW + C_CGATE + h * 64 + dt * 16 + fq * 4); }
        f32x4 sA[10], sB[10];
#pragma unroll
        for (int u = 0; u < 10; ++u) { const LAS bf16_t* kp = Ks + ((qa + u) * 16 + fr) * 72 + fq * 8;
            const bf16x8 k0 = *(const LAS bf16x8*)kp, k1 = *(const LAS bf16x8*)(kp + 32);
            f32x4 z = (f32x4){0.f, 0.f, 0.f, 0.f};
            if (u < 9) { sA[u] = mfma16(k1, qA1, mfma16(k0, qA0, z)); } else sA[u] = z;
            if (u > 0) { sB[u] = mfma16(k1, qB1, mfma16(k0, qB0, z)); } else sB[u] = z; }
        float mxA = sink, mxB = sink;
#pragma unroll
        for (int k9 = 0; k9 < 9; ++k9)
#pragma unroll
            for (int j = 0; j < 4; ++j) { float la = sA[k9][j] + bv[k9][j], lb = sB[k9 + 1][j] + bv[k9][j];
                if (n == 0) { if ((qa + k9) * 16 + fq * 4 + j < 128) la = -1e30f; if ((qa + 1 + k9) * 16 + fq * 4 + j < 128) lb = -1e30f; }
                sA[k9][j] = la; mxA = fmaxf(mxA, la); sB[k9 + 1][j] = lb; mxB = fmaxf(mxB, lb); }
        mxA = fmaxf(mxA, __shfl_xor(mxA, 16)); mxB = fmaxf(mxB, __shfl_xor(mxB, 16)); mxA = fmaxf(mxA, __shfl_xor(mxA, 32)); mxB = fmaxf(mxB, __shfl_xor(mxB, 32));
        float smA = 0.f, smB = 0.f;
#pragma unroll
        for (int k9 = 0; k9 < 9; ++k9)
#pragma unroll
            for (int j = 0; j < 4; ++j) { const float ea = __expf(sA[k9][j] - mxA), eb = __expf(sB[k9 + 1][j] - mxB); sA[k9][j] = ea; smA += ea; sB[k9 + 1][j] = eb; smB += eb; }
        smA += __shfl_xor(smA, 16); smB += __shfl_xor(smB, 16); smA += __shfl_xor(smA, 32); smB += __shfl_xor(smB, 32);
        const float invA = 1.0f / (smA + __expf(sink - mxA)), invB = 1.0f / (smB + __expf(sink - mxB));
        f32x4 oA[4], oB[4];
#pragma unroll
        for (int dt = 0; dt < 4; ++dt) { oA[dt] = (f32x4){0.f, 0.f, 0.f, 0.f}; oB[dt] = oA[dt]; }
#pragma unroll
        for (int pr = 0; pr < 5; ++pr) {
            u32x4 pa; pa.x = pk2(sA[2 * pr][0], sA[2 * pr][1]); pa.y = pk2(sA[2 * pr][2], sA[2 * pr][3]); pa.z = pk2(sA[2 * pr + 1][0], sA[2 * pr + 1][1]); pa.w = pk2(sA[2 * pr + 1][2], sA[2 * pr + 1][3]);
            u32x4 pb; pb.x = pk2(sB[2 * pr][0], sB[2 * pr][1]); pb.y = pk2(sB[2 * pr][2], sB[2 * pr][3]); pb.z = pk2(sB[2 * pr + 1][0], sB[2 * pr + 1][1]); pb.w = pk2(sB[2 * pr + 1][2], sB[2 * pr + 1][3]);
            const bf16x8 pfA = __builtin_bit_cast(bf16x8, pa), pfB = __builtin_bit_cast(bf16x8, pb);
#pragma unroll
            for (int dt = 0; dt < 4; ++dt) { const LAS unsigned* vp = Vt32 + (dt * 16 + fr) * 140 + (qa + 2 * pr) * 8 + fq * 2;
                const u32x2 lo = *(const LAS u32x2*)vp, hi = *(const LAS u32x2*)(vp + 8);
                u32x4 aw; aw.x = lo.x; aw.y = lo.y; aw.z = hi.x; aw.w = hi.y; const bf16x8 af = __builtin_bit_cast(bf16x8, aw);
                oA[dt] = mfma16(af, pfA, oA[dt]); oB[dt] = mfma16(af, pfB, oB[dt]); } }
#pragma unroll
        for (int dt = 0; dt < 4; ++dt) { const int col = h * 64 + dt * 16 + fq * 4;
            u32x2 w; w.x = pk2(oA[dt][0] * invA * bflo(cgA[dt].x), oA[dt][1] * invA * bfhi(cgA[dt].x)); w.y = pk2(oA[dt][2] * invA * bflo(cgA[dt].y), oA[dt][3] * invA * bfhi(cgA[dt].y));
            *(u32x2*)(YC + (size_t)tokA * 1024 + col) = w;
            u32x2 w2; w2.x = pk2(oB[dt][0] * invB * bflo(cgB[dt].x), oB[dt][1] * invB * bfhi(cgB[dt].x)); w2.y = pk2(oB[dt][2] * invB * bflo(cgB[dt].y), oB[dt][3] * invB * bfhi(cgB[dt].y));
            *(u32x2*)(YC + (size_t)tokB * 1024 + col) = w2; }
    }
    __syncthreads();
}

__device__ __forceinline__ void sgu_item(KP p, LAS unsigned char* lds, int l, int n) {
    int tid_ = threadIdx.x; OPAQUE_V(tid_);
    const int tid = tid_, wid = __builtin_amdgcn_readfirstlane(tid >> 6), lane = tid & 63, fr = lane & 15, fq = lane >> 4;
    const bf16_t* HM = (const bf16_t*)(p->ws + WS_HM);
    bf16_t* YB = (bf16_t*)(p->ws + WS_Y) + (size_t)1 * SEQ * 1024;
    LAS bf16_t* vnT = (LAS bf16_t*)lds;
    LAS unsigned* vnT32 = (LAS unsigned*)lds;
    LAS float* stats = (LAS float*)(lds + 139264);
    const float* lng = p->in[4] + l * 1024; const float* lnb = p->in[5] + l * 1024;
#pragma unroll 1
    for (int tb = 0; tb < 16; tb += 4) {
        u32x4 a[4], b[4];
#pragma unroll
        for (int q = 0; q < 4; ++q) { const bf16_t* row = HM + (size_t)(n * 128 + wid * 16 + tb + q) * HMW + C_V; a[q] = *(const u32x4*)(row + lane * 8); b[q] = *(const u32x4*)(row + 512 + lane * 8); }
        float mean[4], rstd[4];
#pragma unroll
        for (int q = 0; q < 4; ++q) { const float sm = ((bflo(a[q].x) + bfhi(a[q].x)) + (bflo(a[q].y) + bfhi(a[q].y))) + ((bflo(a[q].z) + bfhi(a[q].z)) + (bflo(a[q].w) + bfhi(a[q].w)))
                + ((bflo(b[q].x) + bfhi(b[q].x)) + (bflo(b[q].y) + bfhi(b[q].y))) + ((bflo(b[q].z) + bfhi(b[q].z)) + (bflo(b[q].w) + bfhi(b[q].w)));
            mean[q] = sm; }
#pragma unroll
        for (int o = 1; o < 64; o <<= 1) {
#pragma unroll
            for (int q = 0; q < 4; ++q) mean[q] += __shfl_xor(mean[q], o); }
#pragma unroll
        for (int q = 0; q < 4; ++q) { mean[q] *= (1.f / 1024.f); const float m = mean[q];
            const float d0 = bflo(a[q].x) - m, d1 = bfhi(a[q].x) - m, d2 = bflo(a[q].y) - m, d3 = bfhi(a[q].y) - m, d4 = bflo(a[q].z) - m, d5 = bfhi(a[q].z) - m, d6 = bflo(a[q].w) - m, d7 = bfhi(a[q].w) - m;
            const float e0 = bflo(b[q].x) - m, e1 = bfhi(b[q].x) - m, e2 = bflo(b[q].y) - m, e3 = bfhi(b[q].y) - m, e4 = bflo(b[q].z) - m, e5 = bfhi(b[q].z) - m, e6 = bflo(b[q].w) - m, e7 = bfhi(b[q].w) - m;
            rstd[q] = ((d0 * d0 + d1 * d1) + (d2 * d2 + d3 * d3)) + ((d4 * d4 + d5 * d5) + (d6 * d6 + d7 * d7)) + ((e0 * e0 + e1 * e1) + (e2 * e2 + e3 * e3)) + ((e4 * e4 + e5 * e5) + (e6 * e6 + e7 * e7)); }
#pragma unroll
        for (int o = 1; o < 64; o <<= 1) {
#pragma unroll
            for (int q = 0; q < 4; ++q) rstd[q] += __shfl_xor(rstd[q], o); }
        if (lane == 0) {
#pragma unroll
            for (int q = 0; q < 4; ++q) { stats[(wid * 16 + tb + q) * 2] = mean[q]; stats[(wid * 16 + tb + q) * 2 + 1] = rsqrtf(rstd[q] * (1.f / 1024.f) + LN_EPS); } }
    }
    __syncthreads();
#pragma unroll 1
    for (int r = 0; r < 2; ++r) {
        {
            const float m0 = stats[4 * lane], r0 = stats[4 * lane + 1], m1 = stats[4 * lane + 2], r1 = stats[4 * lane + 3];
#pragma unroll 1
            for (int ib = 0; ib < 8; ib += 2) {
                u32x4 ra[2], rb[2];
#pragma unroll
                for (int it = 0; it < 2; ++it) { const int dg = wid + 8 * (ib + it); const bf16_t* row = HM + (size_t)(n * 128 + 2 * lane) * HMW + C_V + r * 512 + dg * 8;
                    ra[it] = *(const u32x4*)row; rb[it] = *(const u32x4*)(row + HMW); }
#pragma unroll
                for (int it = 0; it < 2; ++it) { const int dg = wid + 8 * (ib + it), d0 = dg * 8, col = r * 512 + d0;
                    const f32x4 g0 = *(const f32x4*)(lng + col), g1 = *(const f32x4*)(lng + col + 4), b0 = *(const f32x4*)(lnb + col), b1 = *(const f32x4*)(lnb + col + 4);
                    const u32x4 a = ra[it], b = rb[it];
                    const float av[8] = {bflo(a.x), bfhi(a.x), bflo(a.y), bfhi(a.y), bflo(a.z), bfhi(a.z), bflo(a.w), bfhi(a.w)};
                    const float bv[8] = {bflo(b.x), bfhi(b.x), bflo(b.y), bfhi(b.y), bflo(b.z), bfhi(b.z), bflo(b.w), bfhi(b.w)};
                    const float gv[8] = {g0[0], g0[1], g0[2], g0[3], g1[0], g1[1], g1[2], g1[3]};
                    const float cv[8] = {b0[0], b0[1], b0[2], b0[3], b1[0], b1[1], b1[2], b1[3]};
                    LAS unsigned* o = vnT32 + ((d0 >> 7) * 128 + (d0 & 127)) * 68 + lane;
#pragma unroll
                    for (int i = 0; i < 8; ++i) o[i * 68] = pk2((av[i] - m0) * r0 * gv[i] + cv[i], (bv[i] - m1) * r1 * gv[i] + cv[i]); }
            }
        }
        __syncthreads();
        const int hl = wid >> 1, th = wid & 1, h = 4 * r + hl;
        const float* wbase = p->in[6] + (size_t)(l * 8 + h) * 128 * 128;
#pragma unroll 1
        for (int tti = 0; tti < 4; ++tti) {
            const int t0 = (th * 4 + tti) * 16, t = t0 + fr;
            const int nks = (t0 >> 5) + 1;
            const size_t tok = (size_t)n * 128 + t;
            f32x4 w0[4], w1[4];
#pragma unroll
            for (int ks = 0; ks < 4; ++ks) { w0[ks] = (f32x4){0.f, 0.f, 0.f, 0.f}; w1[ks] = w0[ks];
                if (ks < nks) { const float* wp = wbase + t * 128 + ks * 32 + fq * 8; w0[ks] = *(const f32x4*)wp; w1[ks] = *(const f32x4*)(wp + 4); } }
            u32x2 uu[8];
#pragma unroll
            for (int dt = 0; dt < 8; ++dt) { const int col = h * 128 + dt * 16 + fq * 4; uu[dt] = *(const u32x2*)(HM + tok * HMW + C_UG + col); }
            const float bs = p->in[7][(l * 8 + h) * 128 + t];
            f32x4 acc[8];
#pragma unroll
            for (int dt = 0; dt < 8; ++dt) acc[dt] = (f32x4){0.f, 0.f, 0.f, 0.f};
#pragma unroll
            for (int ks = 0; ks < 4; ++ks) if (ks < nks) { const int s0 = ks * 32 + fq * 8;
                u32x4 bw;
                bw.x = pk2(s0 + 0 <= t ? w0[ks][0] : 0.f, s0 + 1 <= t ? w0[ks][1] : 0.f); bw.y = pk2(s0 + 2 <= t ? w0[ks][2] : 0.f, s0 + 3 <= t ? w0[ks][3] : 0.f);
                bw.z = pk2(s0 + 4 <= t ? w1[ks][0] : 0.f, s0 + 5 <= t ? w1[ks][1] : 0.f); bw.w = pk2(s0 + 6 <= t ? w1[ks][2] : 0.f, s0 + 7 <= t ? w1[ks][3] : 0.f);
                const bf16x8 bf = __builtin_bit_cast(bf16x8, bw);
#pragma unroll
                for (int dt = 0; dt < 8; ++dt) { const bf16x8 af = *(const LAS bf16x8*)(vnT + (hl * 128 + dt * 16 + fr) * 136 + s0);
                    acc[dt] = mfma16(af, bf, acc[dt]); } }
#pragma unroll
            for (int dt = 0; dt < 8; ++dt) { const int col = h * 128 + dt * 16 + fq * 4;
                u32x2 w; w.x = pk2((acc[dt][0] + bs) * bflo(uu[dt].x), (acc[dt][1] + bs) * bfhi(uu[dt].x));
                w.y = pk2((acc[dt][2] + bs) * bflo(uu[dt].y), (acc[dt][3] + bs) * bfhi(uu[dt].y));
                *(u32x2*)(YB + tok * 1024 + col) = w; }
        }
        __syncthreads();
    }
}

__device__ __forceinline__ f32x2 glu_at(const bf16_t* hm, int tok) {
    f32x2 g = (f32x2){0.f, 0.f};
    if (tok >= 0) { const unsigned va = *(const unsigned*)(hm + (size_t)tok * HMW + C_GLU); g = (f32x2){bflo(va), bfhi(va)}; }
    return g;
}
__device__ __forceinline__ void conv_item(KP p, LAS unsigned char* lds, int l, int tile) {
    int tid_ = threadIdx.x; OPAQUE_V(tid_);
    const int tid = tid_, wid = __builtin_amdgcn_readfirstlane(tid >> 6), lane = tid & 63;
    const bf16_t* HM = (const bf16_t*)(p->ws + WS_HM);
    bf16_t* YD = (bf16_t*)(p->ws + WS_Y) + (size_t)3 * SEQ * 1024;
    LAS float* ybuf = (LAS float*)lds;
    const int t0 = tile * 32, c0 = 2 * tid;
    const bf16_t* hm = HM + c0;
    f32x2 w[31];
#pragma unroll
    for (int j = 0; j < 31; ++j) w[j] = *(const f32x2*)(p->in[10] + (size_t)(l * 31 + j) * 1024 + c0);
    const f32x2 cb = *(const f32x2*)(p->in[11] + l * 1024 + c0);
    f32x2 g[34];
#pragma unroll
    for (int i = 0; i < 30; ++i) g[i] = glu_at(hm, t0 - 30 + i);
    unsigned nv[4];
#pragma unroll
    for (int q = 0; q < 4; ++q) nv[q] = *(const unsigned*)(hm + (size_t)(t0 + q) * HMW + C_GLU);
#pragma unroll 1
    for (int blk = 0; blk < 8; ++blk) {
#pragma unroll
        for (int q = 0; q < 4; ++q) g[30 + q] = (f32x2){bflo(nv[q]), bfhi(nv[q])};
        { const int tn = t0 + (blk < 7 ? blk + 1 : blk) * 4;
#pragma unroll
          for (int q = 0; q < 4; ++q) nv[q] = *(const unsigned*)(hm + (size_t)(tn + q) * HMW + C_GLU); }
        f32x2 y[4] = {cb, cb, cb, cb};
#pragma unroll
        for (int j = 0; j < 31; ++j)
#pragma unroll
            for (int q = 0; q < 4; ++q) y[q] += w[j] * g[q + j];
#pragma unroll
        for (int q = 0; q < 4; ++q) *(LAS f32x2*)(ybuf + (blk * 4 + q) * 1024 + c0) = y[q];
#pragma unroll
        for (int i = 0; i < 30; ++i) g[i] = g[i + 4];
    }
    __syncthreads();
    const float* lng = p->in[12] + l * 1024; const float* lnb = p->in[13] + l * 1024;
    for (int tt = 0; tt < 4; ++tt) { const int o = wid * 4 + tt; const size_t tok = (size_t)t0 + o;
        f32x4 v[4]; float sm = 0.f;
#pragma unroll
        for (int j = 0; j < 4; ++j) { v[j] = *(const LAS f32x4*)(ybuf + o * 1024 + lane * 4 + 256 * j); sm += (v[j][0] + v[j][1]) + (v[j][2] + v[j][3]); }
        const float mean = wave_sum(sm) * (1.f / 1024.f); float sq = 0.f;
#pragma unroll
        for (int j = 0; j < 4; ++j) { v[j] = v[j] - mean; sq += (v[j][0] * v[j][0] + v[j][1] * v[j][1]) + (v[j][2] * v[j][2] + v[j][3] * v[j][3]); }
        const float rstd = rsqrtf(wave_sum(sq) * (1.f / 1024.f) + LN_EPS);
#pragma unroll
        for (int j = 0; j < 4; ++j) { const int c = lane * 4 + 256 * j;
            const f32x4 gg = *(const f32x4*)(lng + c), bb = *(const f32x4*)(lnb + c);
            const u32x2 gt = *(const u32x2*)(HM + tok * HMW + C_DGATE + c);
            const f32x4 y = v[j] * rstd * gg + bb;
            u32x2 wv; wv.x = pk2(siluf_(y[0]) * bflo(gt.x), siluf_(y[1]) * bfhi(gt.x)); wv.y = pk2(siluf_(y[2]) * bflo(gt.y), siluf_(y[3]) * bfhi(gt.y));
            *(u32x2*)(YD + tok * 1024 + c) = wv; } }
    __syncthreads();
}

__device__ __forceinline__ void pool_item(KP p, int n) {
    int tid_ = threadIdx.x; OPAQUE_V(tid_); const int tid = tid_;
    const bf16_t* HM = (const bf16_t*)(p->ws + WS_HM);
    bf16_t* MIX = (bf16_t*)(p->ws + WS_MIX);
    const int c = (tid & 127) * 8, tq = tid >> 7, g = c >> 8, w = 2 << g;
    const int ts = n * 128 + tq * 32;
    float s[8];
#pragma unroll
    for (int i = 0; i < 8; ++i) s[i] = 0.f;
    for (int tau = 1; tau <= w; ++tau) { const int tok = ts - tau; if (tok >= 0) { const u32x4 a = *(const u32x4*)(HM + (size_t)tok * HMW + C_AIN + c);
            s[0] += bflo(a.x); s[1] += bfhi(a.x); s[2] += bflo(a.y); s[3] += bfhi(a.y); s[4] += bflo(a.z); s[5] += bfhi(a.z); s[6] += bflo(a.w); s[7] += bfhi(a.w); } }
#pragma unroll 1
    for (int tb = ts; tb < ts + 32; tb += 8) {
        u32x4 av[8], bv[8];
#pragma unroll
        for (int q = 0; q < 8; ++q) { const int t = tb + q; av[q] = *(const u32x4*)(HM + (size_t)t * HMW + C_AIN + c);
            bv[q] = (u32x4){0u, 0u, 0u, 0u}; if (t - w >= 0) bv[q] = *(const u32x4*)(HM + (size_t)(t - w) * HMW + C_AIN + c); }
#pragma unroll
        for (int q = 0; q < 8; ++q) { const int t = tb + q; const u32x4 a = av[q], b = bv[q];
            const float cur[8] = {bflo(a.x), bfhi(a.x), bflo(a.y), bfhi(a.y), bflo(a.z), bfhi(a.z), bflo(a.w), bfhi(a.w)};
            const float old[8] = {bflo(b.x), bfhi(b.x), bflo(b.y), bfhi(b.y), bflo(b.z), bfhi(b.z), bflo(b.w), bfhi(b.w)};
            const float rc = 1.0f / (float)(t + 1 < w ? t + 1 : w);
            float m[8];
#pragma unroll
            for (int i = 0; i < 8; ++i) { s[i] = s[i] + cur[i] - old[i]; m[i] = s[i] * rc - cur[i]; }
            u32x4 o; o.x = pk2(m[0], m[1]); o.y = pk2(m[2], m[3]); o.z = pk2(m[4], m[5]); o.w = pk2(m[6], m[7]);
            *(u32x4*)(MIX + ((size_t)g * SEQ + t) * 256 + (c & 255)) = o; }
    }
}

#ifndef GEMM_ALIGN
#define GEMM_ALIGN true
#endif
#ifndef GEMM_SP2
#define GEMM_SP2 true
#endif
constexpr int GEMM1_EXTRA = 64;
constexpr int CW_QUEUE = 3584;
__device__ __forceinline__ void phase_mixers(KP p, LAS unsigned char* lds, int l) {
    unsigned* head = (unsigned*)(p->ws + WS_CTL) + CW_QUEUE + 64 * l;
    volatile LAS unsigned* qslot = (volatile LAS unsigned*)(lds + LDS_BYTES - 64) + 8;
    for (;;) {
        __syncthreads();
        if (threadIdx.x == 0) qslot[0] = __hip_atomic_fetch_add(head, 1u, __ATOMIC_RELAXED, __HIP_MEMORY_SCOPE_AGENT);
        __syncthreads();
        const int it = __builtin_amdgcn_readfirstlane((int)qslot[0]);
        if (it >= 1088) break;
        if (it < 64) {
            unsigned char* ws = p->ws;
            pg8::Gemm g{(const bf16_t*)(ws + WS_XB), (const bf16_t*)(ws + WS_WIN + l * SZ_WIN), SEQ, DIN, DM};
            pg8::ExtraOrder S{it, DIN / 256 - 1};
            pg8::EpiH E{(bf16_t*)(ws + WS_HM), (bf16_t*)(ws + WS_HG)};
            pg8::gemm_phase<GEMM_ALIGN, GEMM_SP2>(lds, g, S, E);
        }
        else if (it < 192) sgu_item(p, lds, l, it - 64);
        else if (it < 448) attn_item(p, lds, l, (it - 192) >> 1, (it - 192) & 1);
        else if (it < 960) conv_item(p, lds, l, it - 448);
        else pool_item(p, it - 960);
    }
}

__device__ __forceinline__ void phase_ln(KP p, int l) {
    int tid_ = threadIdx.x; OPAQUE_V(tid_); const int tid = tid_, wid = tid >> 6, lane = tid & 63;
    const float* lng = p->in[16] + l * DM; const float* lnb = p->in[17] + l * DM;
    bf16_t* xb = (bf16_t*)(p->ws + WS_XB);
    for (int row = blockIdx.x * 8 + wid; row < SEQ; row += gridDim.x * 8) {
        float* xr = p->out + (size_t)row * DM + lane * 4;
        f32x4 v[8]; float sm = 0.f;
#pragma unroll
        for (int j = 0; j < 8; ++j) { v[j] = *(const f32x4*)(xr + 256 * j); sm += (v[j][0] + v[j][1]) + (v[j][2] + v[j][3]); }
        const float mean = wave_sum(sm) * (1.f / DM); float sq = 0.f;
#pragma unroll
        for (int j = 0; j < 8; ++j) { v[j] = v[j] - mean; sq += (v[j][0] * v[j][0] + v[j][1] * v[j][1]) + (v[j][2] * v[j][2] + v[j][3] * v[j][3]); }
        const float rstd = rsqrtf(wave_sum(sq) * (1.f / DM) + LN_EPS);
#pragma unroll
        for (int j = 0; j < 8; ++j) { const int c = lane * 4 + 256 * j;
            const f32x4 y = v[j] * rstd * *(const f32x4*)(lng + c) + *(const f32x4*)(lnb + c);
            *(f32x4*)(xr + 256 * j) = y;
            if (l + 1 < DEPTH) { u32x2 wv; wv.x = pk2(y[0], y[1]); wv.y = pk2(y[2], y[3]); *(u32x2*)(xb + (size_t)row * DM + c) = wv; } }
    }
}


#define XB_TMO      128
#define XB_XCNT(j)  (256  + 64 * (j))
#define XB_XSUB(j)  (1280 + 64 * (j))
#define XB_XGEN(j)  (2304 + 64 * (j))
#define XB_TOP      3328
#define XB_TOPGEN   3392
#define XCD_BAR_WORDS 3456
#define XB_SPIN_CAP (1u << 18)
__device__ __forceinline__ unsigned xb_ld(unsigned* p)              { return __hip_atomic_load(p, __ATOMIC_RELAXED, __HIP_MEMORY_SCOPE_AGENT); }
__device__ __forceinline__ unsigned xb_add(unsigned* p, unsigned v) { return __hip_atomic_fetch_add(p, v, __ATOMIC_RELAXED, __HIP_MEMORY_SCOPE_AGENT); }
__device__ __forceinline__ unsigned xb_xcc_id() { return (unsigned)__builtin_amdgcn_s_getreg((3 << 11) | 20) & 0xFu; }
#define XB_SPIN(cond, bar) do { unsigned _sp = 0; while (cond) { __builtin_amdgcn_s_sleep(1); \
    if ((++_sp & 255u) == 0u) { if (xb_ld(&(bar)[XB_TMO])) break; if (_sp > XB_SPIN_CAP) { atomicAdd(&(bar)[XB_TMO], 1u); break; } } } } while (0)
struct XcdBarrier { unsigned* bar; unsigned x; volatile LAS unsigned* st; };
__device__ __forceinline__ XcdBarrier xcd_barrier_post(unsigned* bar, volatile LAS unsigned* st) {
    XcdBarrier b; b.bar = bar; b.x = xb_xcc_id(); b.st = st;
    if (threadIdx.x == 0) (void)xb_add(&bar[XB_XCNT(b.x)], 1u);
    return b;
}
__device__ __forceinline__ void xcd_barrier_complete(unsigned* bar, unsigned x, unsigned& nloc, unsigned& nx) {
    const unsigned G = gridDim.x * gridDim.y * gridDim.z;
    unsigned sum, cnt, mine, sp = 0u;
    for (;;) {
        sum = 0u; cnt = 0u; mine = 0u;
#pragma unroll
        for (unsigned j = 0; j < 16; ++j) { const unsigned c = xb_ld(&bar[XB_XCNT(j)]); sum += c; cnt += (c > 0u) ? 1u : 0u; mine = (j == x) ? c : mine; }
        if (sum == G) break;
        __builtin_amdgcn_s_sleep(1);
        if ((++sp & 255u) == 0u) { if (xb_ld(&bar[XB_TMO])) break; if (sp > XB_SPIN_CAP) { atomicAdd(&bar[XB_TMO], 1u); break; } }
    }
    nloc = mine > 0u ? mine : 1u; nx = cnt > 0u ? cnt : 1u;
}
__device__ __forceinline__ void xcd_barrier(const XcdBarrier& b) {
    asm volatile("s_waitcnt vmcnt(0)" ::: "memory");
    __syncthreads();
    if (threadIdx.x == 0) {
        unsigned* bar = b.bar;
        __builtin_amdgcn_s_waitcnt(0);
        unsigned nloc = b.st[0], nx = b.st[1];
        if (nloc == 0u) { xcd_barrier_complete(bar, b.x, nloc, nx); b.st[0] = nloc; b.st[1] = nx; }
        const unsigned old = xb_add(&bar[XB_XSUB(b.x)], 1u);
        const unsigned gen = old / nloc;
        if (old + 1u == (gen + 1u) * nloc) {
            __builtin_amdgcn_fence(__ATOMIC_RELEASE, "agent");
            asm volatile("s_waitcnt vmcnt(0)" ::: "memory");
            const unsigned og = xb_add(&bar[XB_TOP], 1u);
            const unsigned tg = og / nx;
            if (og + 1u == (tg + 1u) * nx) xb_add(&bar[XB_TOPGEN], 1u);
            else XB_SPIN(xb_ld(&bar[XB_TOPGEN]) == tg, bar);
            __builtin_amdgcn_fence(__ATOMIC_ACQUIRE, "agent");
            xb_add(&bar[XB_XGEN(b.x)], 1u);
            asm volatile("s_waitcnt vmcnt(0)" ::: "memory");
        } else {
            XB_SPIN(xb_ld(&bar[XB_XGEN(b.x)]) == gen, bar);
            __builtin_amdgcn_fence(__ATOMIC_ACQUIRE, "agent");
            asm volatile("s_waitcnt vmcnt(0)" ::: "memory");
        }
    }
    __syncthreads();
}

#ifndef GEMM_ALIGN
#define GEMM_ALIGN true
#endif
#ifndef GEMM_SP2
#define GEMM_SP2 true
#endif
constexpr int N_PHASES = 1 + 6 * DEPTH;
__global__ void __launch_bounds__(512, 2) fwd_megakernel(Params p_unused) {
    extern __shared__ __attribute__((aligned(16))) unsigned char lds_raw[];
    LAS unsigned char* lds = (LAS unsigned char*)lds_raw;
    cg::grid_group grid = cg::this_grid();
    const int lo = kargs()->ph_lo, hi = kargs()->ph_hi;
    volatile LAS unsigned* bst = (volatile LAS unsigned*)(lds + LDS_BYTES - 64);
    if (threadIdx.x < 4) bst[threadIdx.x] = 0u;
    __syncthreads();
    XcdBarrier bar; bar.bar = (unsigned*)(kargs()->ws + WS_CTL); bar.x = xb_xcc_id(); bar.st = bst;
    if (threadIdx.x == 0) bst[3] = xb_add(&bar.bar[XB_XCNT(bar.x)], 1u);
#define IN(k) (lo <= (k) && (k) < hi)
#ifndef REP_MASK
#define REP_MASK 0u
#endif
#define REPS(i) for (int rep_ = 0; rep_ < (((REP_MASK >> (i)) & 1u) ? 2 : 1); ++rep_)
#define SEAM(k) do { if (IN(k) && IN((k) + 1)) xcd_barrier(bar); } while (0)
    if (lo < 0) grid.sync();
    if (IN(0)) REPS(0) { phase_p0(kargs(), lds); }
    SEAM(0);
    if (IN(0) && IN(1)) {
        if (threadIdx.x == 0) {
            bool even = (bst[1] == 8u) && (gridDim.x % 8u == 0u);
            for (unsigned j = 0; j < 16; ++j) { const unsigned c = xb_ld(&bar.bar[XB_XCNT(j)]); if (c != 0u && c != gridDim.x / 8u) even = false; }
            bst[2] = even ? bst[3] * 8u + bar.x : blockIdx.x; }
        __syncthreads();
    } else if (threadIdx.x == 0) bst[2] = blockIdx.x;
    __syncthreads();
    const int vc = (int)bst[2];
    for (int l = 0; l < DEPTH; ++l) {
        const int pb = 1 + 6 * l; KP p = kargs(); unsigned char* ws = p->ws;
        if (IN(pb + 0)) REPS(1) {
            pg8::Gemm g{(const bf16_t*)(ws + WS_XB), (const bf16_t*)(ws + WS_WIN + l * SZ_WIN), SEQ, DIN, DM};
            pg8::StaticOrder S; S.init(SEQ, DIN - 256, gridDim.x, vc);
            pg8::EpiH E{(bf16_t*)(ws + WS_HM), (bf16_t*)(ws + WS_HG)};
            pg8::gemm_phase<GEMM_ALIGN, GEMM_SP2>(lds, g, S, E);
        }
        SEAM(pb + 0);
        if (IN(pb + 1)) REPS(2) phase_mixers(p, lds, l);
        SEAM(pb + 1);
        if (IN(pb + 2)) REPS(3) {
            pg8::Gemm g{(const bf16_t*)(ws + WS_MIX), (const bf16_t*)(ws + WS_WP) + (size_t)l * 4 * 256 * 256, 4 * SEQ, 256, 256};
            pg8::PoolOrder S{(int)gridDim.x, (int)blockIdx.x};
            pg8::EpiPool E{(const bf16_t*)(ws + WS_HM), (bf16_t*)(ws + WS_Y)};
            pg8::gemm_phase<GEMM_ALIGN, GEMM_SP2>(lds, g, S, E);
        }
        SEAM(pb + 2);
        if (IN(pb + 3)) REPS(4) {
            pg8::Gemm g{(const bf16_t*)(ws + WS_Y), (const bf16_t*)(ws + WS_WB) + (size_t)l * 4 * 2048 * 1024, 4 * SEQ, 4 * 2048, 1024};
            pg8::BrOrder S; S.so.init(SEQ, DM, gridDim.x, vc);
            pg8::EpiBr E{(const bf16_t*)(ws + WS_HG), (bf16_t*)(ws + WS_MG)};
            pg8::gemm_phase<GEMM_ALIGN, GEMM_SP2>(lds, g, S, E);
        }
        SEAM(pb + 3);
        if (IN(pb + 4)) for (int rep_ = 0; rep_ < ((((REP_MASK >> 5) & 1u) && l == 0) ? 2 : 1); ++rep_) {
            pg8::Gemm g{(const bf16_t*)(ws + WS_MG), (const bf16_t*)(ws + WS_WO) + (size_t)l * 2048 * 2048, SEQ, DM, DM};
            pg8::StaticOrder S; S.init(SEQ, DM, gridDim.x, vc);
            pg8::EpiOut E{l == 0 ? p->in[0] : (const float*)p->out, p->out};
            pg8::gemm_phase<GEMM_ALIGN, GEMM_SP2>(lds, g, S, E);
        }
        SEAM(pb + 4);
        if (IN(pb + 5)) phase_ln(p, l);
        if (l + 1 < DEPTH) SEAM(pb + 5);
    }
#undef IN
#undef SEAM
}

extern "C" void kernel_launch(void* const* d_in, const int* in_sizes, int n_in, void* d_out, int out_size, void* d_ws, size_t ws_size, hipStream_t stream) {
    static int grid = 0;
    if (grid == 0) {
        if (n_in != 18 || out_size != SEQ * DM || ws_size < WS_END + CTL_BYTES) { fprintf(stderr, "kernel_launch: unexpected shapes (n_in %d out %d ws %zu need %zu)\n", n_in, out_size, ws_size, (size_t)WS_END); grid = -1; return; }
        int dev = 0, cus = 0, per_cu = 0;
        hipGetDevice(&dev);
        hipDeviceGetAttribute(&cus, hipDeviceAttributeMultiprocessorCount, dev);
        hipFuncSetAttribute((const void*)fwd_megakernel, hipFuncAttributeMaxDynamicSharedMemorySize, LDS_BYTES);
        hipOccupancyMaxActiveBlocksPerMultiprocessor(&per_cu, (const void*)fwd_megakernel, 512, LDS_BYTES);
        if (per_cu < 1) { fprintf(stderr, "kernel_launch: occupancy query says %d blocks per CU\n", per_cu); per_cu = 1; }
        grid = cus * per_cu;
        (void)hipGetLastError();
    }
    if (grid < 0) return;
    Params p{};
    for (int i = 0; i < 18; ++i) p.in[i] = (const float*)d_in[i];
    p.out = (float*)d_out; p.ws = (unsigned char*)d_ws;
#if N_LAUNCH_MODE == 1
    p.ph_lo = 0; p.ph_hi = N_PHASES;
    if (hipMemsetAsync((char*)d_ws + WS_CTL, 0, CTL_BYTES, stream) != hipSuccess) { fprintf(stderr, "kernel_launch: memset of barrier words failed\n"); return; }
    void* args[] = {&p};
    hipError_t e = hipLaunchCooperativeKernel((const void*)fwd_megakernel, dim3(grid), dim3(512), args, LDS_BYTES, stream);
    if (e != hipSuccess) fprintf(stderr, "cooperative launch failed: %s (grid %d)\n", hipGetErrorString(e), grid);
#else
    for (int ph = 0; ph < N_PHASES; ++ph) {
        p.ph_lo = ph; p.ph_hi = ph + 1;
        hipLaunchKernelGGL(fwd_megakernel, dim3(grid), dim3(512), LDS_BYTES, stream, p);
    }
#endif
}
```
